# Optimizing an MI355X kernel written in HIP

```python
import math
import jax, jax.numpy as jnp
from jax import lax
import numpy as np

D_MODEL = 1024
BATCH = 4
SEQ = 8192
DEPTH = 2

HEAD_DIM = 64
GRID_W = 64
BLOCK = 128
NA_HEADS = 8
NA_ROW_K = 8
NA_COL_K = 16
SW_Q_HEADS = 8
SW_KV_HEADS = 2
SW_WINDOW = 128
DIFF_HEADS = 4
N_BRANCH = 3
BRANCH_W = 512
D_FF = 2816
ROPE_THETA = 10000.0
EPS = 1e-6
NEG = -1e30

A_W = NA_HEADS * HEAD_DIM
B_QW = SW_Q_HEADS * HEAD_DIM
B_KVW = SW_KV_HEADS * HEAD_DIM
C_QKW = 2 * DIFF_HEADS * HEAD_DIM
C_VW = DIFF_HEADS * 2 * HEAD_DIM
SPLIT_SIZES = (A_W, A_W, A_W, B_QW, B_KVW, B_KVW, C_QKW, C_QKW, C_VW, N_BRANCH * D_MODEL)
IN_COLS = sum(SPLIT_SIZES)

kernel_name = "hybrid_natten_swa_diffattn_macaron_encoder"


def rmsnorm(x, g):
    xf = x.astype(jnp.float32)
    y = xf * lax.rsqrt(jnp.mean(xf * xf, axis=-1, keepdims=True) + EPS)
    return (y * g.astype(jnp.float32)).astype(x.dtype)


def swiglu(x, w_gu, w_down):
    gate, up = jnp.split(x @ w_gu, 2, axis=-1)
    return (jax.nn.silu(gate) * up) @ w_down


def rope_tables(s):
    pos = jnp.arange(s, dtype=jnp.float32)
    inv = ROPE_THETA ** (-jnp.arange(0, HEAD_DIM, 2, dtype=jnp.float32) / HEAD_DIM)
    ang = pos[:, None] * inv[None, :]
    ang = jnp.concatenate([ang, ang], axis=-1)
    return jnp.cos(ang), jnp.sin(ang)


def apply_rope(t, cos, sin):
    t1, t2 = jnp.split(t, 2, axis=-1)
    rot = jnp.concatenate([-t2, t1], axis=-1)
    return t * cos.astype(t.dtype) + rot * sin.astype(t.dtype)


def split_heads(t, n):
    b, s, _ = t.shape
    return t.reshape(b, s, n, HEAD_DIM).transpose(0, 2, 1, 3)


def neighbourhood_attention(q, k, v, rpb):
    b, h, s, d = q.shape
    rows = s // GRID_W
    kr = min(NA_ROW_K, rows)
    kc = NA_COL_K
    r = jnp.arange(rows)
    c = jnp.arange(GRID_W)
    row_start = jnp.clip(r - kr // 2, 0, rows - kr)
    col_start = jnp.clip(c - kc // 2, 0, GRID_W - kc)
    key_rows = row_start[:, None] + jnp.arange(kr)[None, :]
    qg = q.reshape(b, h, rows, GRID_W, d)
    kg = k.reshape(b, h, rows, GRID_W, d)[:, :, key_rows]
    vg = v.reshape(b, h, rows, GRID_W, d)[:, :, key_rows]
    scores = jnp.einsum('bhrcd,bhrijd->bhrcij', qg, kg).astype(jnp.float32) * (d ** -0.5)
    dr = key_rows - r[:, None] + (NA_ROW_K - 1)
    dc = jnp.clip(c[None, :] - c[:, None] + (NA_COL_K - 1), 0, 2 * NA_COL_K - 2)
    bias = rpb[:, dr[:, None, :, None], dc[None, :, None, :]]
    col_ok = (c[None, :] >= col_start[:, None]) & (c[None, :] < col_start[:, None] + kc)
    scores = scores + bias[None].astype(jnp.float32)
    scores = jnp.where(col_ok[None, None, None, :, None, :], scores, NEG)
    p = jax.nn.softmax(scores.reshape(b, h, rows, GRID_W, kr * GRID_W), axis=-1)
    p = p.reshape(b, h, rows, GRID_W, kr, GRID_W).astype(v.dtype)
    out = jnp.einsum('bhrcij,bhrijd->bhrcd', p, vg)
    return out.reshape(b, h, s, d)


def sliding_window_attention(q, k, v, sink):
    b, hq, s, d = q.shape
    hkv = k.shape[1]
    g = hq // hkv
    nb = s // BLOCK
    qb = q.reshape(b, hkv, g, nb, BLOCK, d)

    def band(t):
        tp = jnp.pad(t, ((0, 0), (0, 0), (BLOCK, BLOCK), (0, 0))).reshape(b, hkv, nb + 2, BLOCK, d)
        return jnp.concatenate([tp[:, :, :-2], tp[:, :, 1:-1], tp[:, :, 2:]], axis=3)

    kb, vb = band(k), band(v)
    scores = jnp.einsum('bkgnqd,bknjd->bkgnqj', qb, kb).astype(jnp.float32) * (d ** -0.5)
    qpos = jnp.arange(nb)[:, None] * BLOCK + jnp.arange(BLOCK)[None, :]
    kpos = (jnp.arange(nb)[:, None] - 1) * BLOCK + jnp.arange(3 * BLOCK)[None, :]
    ok = ((jnp.abs(qpos[:, :, None] - kpos[:, None, :]) <= SW_WINDOW)
          & (kpos[:, None, :] >= 0) & (kpos[:, None, :] < s))
    scores = jnp.where(ok, scores, NEG)
    sink_logit = jnp.broadcast_to(sink.astype(jnp.float32).reshape(1, hkv, g, 1, 1, 1),
                                  scores.shape[:-1] + (1,))
    p = jax.nn.softmax(jnp.concatenate([scores, sink_logit], axis=-1), axis=-1)[..., :-1]
    out = jnp.einsum('bkgnqj,bknjd->bkgnqd', p.astype(v.dtype), vb)
    return out.reshape(b, hq, s, d)


def differential_attention(q, k, v, lam, lam_init, subln_g):
    b, h, _, s, d = q.shape
    nb = s // BLOCK
    qb = jnp.moveaxis(q.reshape(b, h, 2, nb, BLOCK, d), 3, 0)

    def one_block(qblk):
        sc = jnp.einsum('bhtqd,bhtkd->bhtqk', qblk, k).astype(jnp.float32) * (d ** -0.5)
        p = jax.nn.softmax(sc, axis=-1)
        a = p[:, :, 0] - lam * p[:, :, 1]
        return jnp.einsum('bhqk,bhke->bhqe', a.astype(v.dtype), v)

    o = lax.map(one_block, qb)
    o = jnp.moveaxis(o, 0, 2).reshape(b, h, s, 2 * d)
    return rmsnorm(o, subln_g) * (1.0 - lam_init)


def setup_inputs(seed: int = 0) -> dict:
    key = jax.random.key(seed)
    ks = jax.random.split(key, 24)
    L, D, F = DEPTH, D_MODEL, D_FF

    def nrm(k, shape, scale):
        return jax.random.normal(k, shape, jnp.float32) * scale

    def gain(k, n):
        return 1.0 + nrm(k, (L, n), 0.05)

    return {
        "x": nrm(ks[0], (BATCH, SEQ, D), 1.0),
        "ffn1_pre_g": gain(ks[1], D),
        "ffn1_w_gu": nrm(ks[2], (L, D, 2 * F), D ** -0.5),
        "ffn1_w_down": nrm(ks[3], (L, F, D), F ** -0.5),
        "ffn1_post_g": gain(ks[4], D),
        "mix_pre_g": gain(ks[5], D),
        "w_in": nrm(ks[6], (L, D, IN_COLS), D ** -0.5),
        "na_rpb": nrm(ks[7], (L, NA_HEADS, 2 * NA_ROW_K - 1, 2 * NA_COL_K - 1), 0.5),
        "sw_sink": nrm(ks[8], (L, SW_Q_HEADS), 1.0),
        "diff_lambda_q1": nrm(ks[9], (L, HEAD_DIM), 0.1),
        "diff_lambda_k1": nrm(ks[10], (L, HEAD_DIM), 0.1),
        "diff_lambda_q2": nrm(ks[11], (L, HEAD_DIM), 0.1),
        "diff_lambda_k2": nrm(ks[12], (L, HEAD_DIM), 0.1),
        "diff_subln_g": gain(ks[13], 2 * HEAD_DIM),
        "w_branch": nrm(ks[14], (L, N_BRANCH, BRANCH_W, D), BRANCH_W ** -0.5),
        "b_gate": nrm(ks[15], (L, N_BRANCH, D), 0.1),
        "w_out": nrm(ks[16], (L, D, D), D ** -0.5),
        "mix_post_g": gain(ks[17], D),
        "ffn2_pre_g": gain(ks[18], D),
        "ffn2_w_gu": nrm(ks[19], (L, D, 2 * F), D ** -0.5),
        "ffn2_w_down": nrm(ks[20], (L, F, D), F ** -0.5),
        "ffn2_post_g": gain(ks[21], D),
    }


def reference(x, ffn1_pre_g, ffn1_w_gu, ffn1_w_down, ffn1_post_g, mix_pre_g, w_in, na_rpb,
              sw_sink, diff_lambda_q1, diff_lambda_k1, diff_lambda_q2, diff_lambda_k2,
              diff_subln_g, w_branch, b_gate, w_out, mix_post_g, ffn2_pre_g, ffn2_w_gu,
              ffn2_w_down, ffn2_post_g):
    b, s, _ = x.shape
    cos, sin = rope_tables(s)
    split_at = np.cumsum(SPLIT_SIZES)[:-1].tolist()
    h = x
    for l in range(DEPTH):
        y = swiglu(rmsnorm(h, ffn1_pre_g[l]), ffn1_w_gu[l], ffn1_w_down[l])
        h = h + 0.5 * rmsnorm(y, ffn1_post_g[l])

        u = rmsnorm(h, mix_pre_g[l])
        proj = u @ w_in[l]
        qa, ka, va, qb, kb, vb, qc, kc, vc, gl = jnp.split(proj, split_at, axis=-1)

        oa = neighbourhood_attention(split_heads(qa, NA_HEADS), split_heads(ka, NA_HEADS),
                                     split_heads(va, NA_HEADS), na_rpb[l])
        oa = oa.transpose(0, 2, 1, 3).reshape(b, s, A_W)

        ob = sliding_window_attention(apply_rope(split_heads(qb, SW_Q_HEADS), cos, sin),
                                      apply_rope(split_heads(kb, SW_KV_HEADS), cos, sin),
                                      split_heads(vb, SW_KV_HEADS), sw_sink[l])
        ob = ob.transpose(0, 2, 1, 3).reshape(b, s, B_QW)

        qc = apply_rope(qc.reshape(b, s, DIFF_HEADS, 2, HEAD_DIM).transpose(0, 2, 3, 1, 4), cos, sin)
        kc = apply_rope(kc.reshape(b, s, DIFF_HEADS, 2, HEAD_DIM).transpose(0, 2, 3, 1, 4), cos, sin)
        vc = vc.reshape(b, s, DIFF_HEADS, 2 * HEAD_DIM).transpose(0, 2, 1, 3)
        lam_init = 0.8 - 0.6 * math.exp(-0.3 * l)
        lam = (jnp.exp(jnp.sum(diff_lambda_q1[l].astype(jnp.float32) * diff_lambda_k1[l].astype(jnp.float32)))
               - jnp.exp(jnp.sum(diff_lambda_q2[l].astype(jnp.float32) * diff_lambda_k2[l].astype(jnp.float32)))
               + lam_init)
        oc = differential_attention(qc, kc, vc, lam, lam_init, diff_subln_g[l])
        oc = oc.transpose(0, 2, 1, 3).reshape(b, s, C_VW)

        branches = jnp.stack([oa, ob, oc], axis=2)
        yb = jnp.einsum('bsnc,ncd->bsnd', branches, w_branch[l])
        gates = jax.nn.sigmoid(gl.reshape(b, s, N_BRANCH, D_MODEL) + b_gate[l])
        merged = jnp.sum(gates * yb, axis=2)
        h = h + rmsnorm(merged @ w_out[l], mix_post_g[l])

        y = swiglu(rmsnorm(h, ffn2_pre_g[l]), ffn2_w_gu[l], ffn2_w_down[l])
        h = h + 0.5 * rmsnorm(y, ffn2_post_g[l])
    return h
```

```cpp
#include <hip/hip_runtime.h>
#include <hip/hip_cooperative_groups.h>
#include <cstdio>
#include <cstdint>
namespace cg = cooperative_groups;

__device__ __forceinline__ int opaque_tid() { int t = threadIdx.x; asm volatile("" : "+v"(t)); return t; }
__device__ __forceinline__ int opaque_s(int x) { asm volatile("" : "+s"(x)); return x; }

#define GASQ __attribute__((address_space(1)))
template <class T> __device__ __forceinline__ T* as_global(T* p) { return (T*)(GASQ T*)p; }
__device__ __forceinline__ void gsync(cg::grid_group& g) {
    asm volatile("s_waitcnt vmcnt(0)" ::: "memory");
    g.sync();
    if (threadIdx.x < 64) {
        __builtin_amdgcn_fence(__ATOMIC_ACQUIRE, "agent");
        asm volatile("s_waitcnt vmcnt(0)" ::: "memory");
    }
    __syncthreads();
}

__device__ __forceinline__ void group_sync(unsigned* cnt, unsigned& target, unsigned& same_xcd) {
    asm volatile("s_waitcnt vmcnt(0)" ::: "memory");
    __syncthreads();
    target += 4u;
    if (threadIdx.x < 64) {
        if (!same_xcd) { __builtin_amdgcn_fence(__ATOMIC_RELEASE, "agent"); asm volatile("s_waitcnt vmcnt(0)" ::: "memory"); }
        if (threadIdx.x == 0) __hip_atomic_fetch_add(cnt, 1u, __ATOMIC_RELAXED, __HIP_MEMORY_SCOPE_AGENT);
        while (__hip_atomic_load(cnt, __ATOMIC_RELAXED, __HIP_MEMORY_SCOPE_AGENT) < target) __builtin_amdgcn_s_sleep(2);
        __builtin_amdgcn_fence(__ATOMIC_ACQUIRE, "agent");
        asm volatile("s_waitcnt vmcnt(0)" ::: "memory");
        const unsigned mask = __hip_atomic_load(cnt + 1, __ATOMIC_RELAXED, __HIP_MEMORY_SCOPE_AGENT);
        same_xcd = (__builtin_popcount(mask) == 1) ? 1u : 0u;
    }
    __syncthreads();
}

namespace pg8 {
#define PG8_LAS __attribute__((address_space(3)))
typedef unsigned short bf16_t;
typedef short bf16x8 __attribute__((ext_vector_type(8)));
typedef float f32x4 __attribute__((ext_vector_type(4)));
typedef unsigned u32x4 __attribute__((ext_vector_type(4)));
constexpr int BM = 256, BK = 64, HALF = 128, HTB = HALF * BK * 2  , STAGE_BYTES = 8 * HTB, NXCD = 8, WGM = 8;

__host__ __device__ __forceinline__ int lds_byte(int r, int c) { const int st = (r >> 4) * 2 + (c >> 5), rr = r & 15, cc = c & 31, ob = rr * 64 + cc * 2; return st * 1024 + (ob ^ (((ob >> 9) & 1) << 5)); }
__host__ __device__ __forceinline__ void stage_rc(int b, int& R, int& C) { const int st = b / 1024, sb = b % 1024, swz = sb ^ (((sb >> 9) & 1) << 5); R = (st >> 1) * 16 + swz / 64; C = (st & 1) * 32 + (swz % 64) / 2; }
__host__ __device__ __forceinline__ int perm32(int rho) { const int n = rho >> 4, i = rho & 15; return 8 * (i >> 2) + 4 * n + (i & 3); }

struct Unit { int pm, pn; };
struct Gemm { const bf16_t* A; const bf16_t* Bt; int M, N, K; int adiv; size_t astride; int lda; };

struct StaticOrder {
    int nM, nN, nwg, G, c;
    __host__ __device__ void init(int M, int N, int G_, int c_) { nM = M / BM; nN = N / BM; nwg = nM * nN; G = G_; c = c_; }
    __host__ __device__ bool next(int i, Unit& u) const {
        const long L = (long)i * G + c; if (L >= nwg) return false;
        int wgid = (int)L; { const int q = nwg / NXCD, r = nwg % NXCD, xcd = wgid % NXCD, off = wgid / NXCD; wgid = (xcd < r ? xcd * (q + 1) : r * (q + 1) + (xcd - r) * q) + off; }
        const int nig = WGM * nN, gid = wgid / nig, fm = gid * WGM, gsz = (nM - fm) < WGM ? (nM - fm) : WGM;
        u.pm = fm + ((wgid % nig) % gsz); u.pn = (wgid % nig) / gsz; return true;
    }
    __device__ __forceinline__ void a_ready(const Unit&) const {}
    __device__ __forceinline__ void done(const Unit&) const {}
};


__device__ __forceinline__ unsigned cvt_pk_bf16(float lo, float hi) { unsigned r; asm volatile("s_nop 1\n\tv_cvt_pk_bf16_f32 %0, %1, %2" : "=v"(r) : "v"(lo), "v"(hi)); return r; }
__device__ __forceinline__ float bf_lo(unsigned w) { return __uint_as_float(w << 16); }
__device__ __forceinline__ float bf_hi(unsigned w) { return __uint_as_float(w & 0xffff0000u); }
__device__ __forceinline__ float sigmoidf_fast(float x) { return __builtin_amdgcn_rcpf(1.0f + __builtin_amdgcn_exp2f(-1.4426950408889634f * x)); }

struct EpiSwiGLU {
    static constexpr bool PERM = true, AFTER_DRAIN = false;
    bf16_t* O; int ldc;
    __device__ __forceinline__ void operator()(const f32x4 (&acc)[2][2][4][2], const Unit& u, int wr, int wc, int fr, int fq) const {
        const int row0 = u.pm * BM + wr * 64 + fr, col0 = u.pn * HALF + wc * 32 + 8 * fq;
#pragma unroll
        for (int ai = 0; ai < 2; ++ai)
#pragma unroll
            for (int m = 0; m < 4; ++m) { bf16_t* rowp = O + (size_t)(row0 + ai * HALF + m * 16) * ldc + col0;
                float v[8];
#pragma unroll
                for (int n = 0; n < 2; ++n)
#pragma unroll
                    for (int e = 0; e < 4; ++e) { const float g = acc[ai][0][m][n][e], up = acc[ai][1][m][n][e]; v[n * 4 + e] = g * sigmoidf_fast(g) * up; }
                u32x4 w; w.x = cvt_pk_bf16(v[0], v[1]); w.y = cvt_pk_bf16(v[2], v[3]); w.z = cvt_pk_bf16(v[4], v[5]); w.w = cvt_pk_bf16(v[6], v[7]);
                *(u32x4*)rowp = w; }
    }
};
struct EpiF32 {
    static constexpr bool PERM = false, AFTER_DRAIN = false;
    float* Y; int ldc;
    __device__ __forceinline__ void operator()(const f32x4 (&acc)[2][2][4][2], const Unit& u, int wr, int wc, int fr, int fq) const {
        const int row0 = u.pm * BM + wr * 64 + fr, col0 = u.pn * BM + wc * 32 + 4 * fq;
#pragma unroll
        for (int ai = 0; ai < 2; ++ai)
#pragma unroll
            for (int m = 0; m < 4; ++m) { float* rowp = Y + (size_t)(row0 + ai * HALF + m * 16) * ldc + col0;
#pragma unroll
                for (int bj = 0; bj < 2; ++bj)
#pragma unroll
                    for (int n = 0; n < 2; ++n) *(f32x4*)(rowp + bj * HALF + n * 16) = acc[ai][bj][m][n]; }
    }
};
struct EpiY16 {
    static constexpr bool PERM = true, AFTER_DRAIN = false;
    bf16_t* Y; int ldc;
    __device__ __forceinline__ void operator()(const f32x4 (&acc)[2][2][4][2], const Unit& u, int wr, int wc, int fr, int fq) const {
        const int row0 = u.pm * BM + wr * 64 + fr, col0 = u.pn * BM + wc * 32 + 8 * fq;
#pragma unroll
        for (int ai = 0; ai < 2; ++ai)
#pragma unroll
            for (int m = 0; m < 4; ++m) { bf16_t* rowp = Y + (size_t)(row0 + ai * HALF + m * 16) * ldc + col0;
#pragma unroll
                for (int bj = 0; bj < 2; ++bj) { const f32x4 v0 = acc[ai][bj][m][0], v1 = acc[ai][bj][m][1];
                    u32x4 w; w.x = cvt_pk_bf16(v0[0], v0[1]); w.y = cvt_pk_bf16(v0[2], v0[3]); w.z = cvt_pk_bf16(v1[0], v1[1]); w.w = cvt_pk_bf16(v1[2], v1[3]);
                    *(u32x4*)(rowp + bj * HALF) = w; } }
    }
};
struct EpiQKV {
    static constexpr bool PERM = false, AFTER_DRAIN = false;
    bf16_t* O; int ldc; const float* cosT; const float* sinT;
    __device__ __forceinline__ static bool is_rope(int c128) { return (c128 >= 1536 && c128 < 2176) || (c128 >= 2304 && c128 < 3328); }
    __device__ __forceinline__ void operator()(const f32x4 (&acc)[2][2][4][2], const Unit& u, int wr, int wc, int fr, int fq) const {
        typedef unsigned u32x2v __attribute__((ext_vector_type(2)));
        const int row0 = u.pm * BM + wr * 64 + fr, w2 = wc & 1, dd = 16 * w2 + 4 * fq;
        const bool r0 = is_rope(u.pn * BM), r1 = is_rope(u.pn * BM + HALF);
#pragma unroll
        for (int ai = 0; ai < 2; ++ai)
#pragma unroll
            for (int m = 0; m < 4; ++m) { const int row = row0 + ai * HALF + m * 16; const int s = row & 8191;
                f32x4 cs = (f32x4){1.f, 1.f, 1.f, 1.f}, sn = (f32x4){0.f, 0.f, 0.f, 0.f};
                if (r0 || r1) { cs = *(const f32x4*)(cosT + s * 32 + dd); sn = *(const f32x4*)(sinT + s * 32 + dd); }
#pragma unroll
                for (int bj = 0; bj < 2; ++bj) { const bool rp = bj ? r1 : r0;
                    const f32x4 x1 = acc[ai][bj][m][0], x2 = acc[ai][bj][m][1];
                    f32x4 o1 = x1, o2 = x2;
                    if (rp) { o1 = x1 * cs - x2 * sn; o2 = x2 * cs + x1 * sn; }
                    bf16_t* p = O + (size_t)row * ldc + u.pn * BM + bj * HALF + (wc >> 1) * 64 + dd;
                    u32x2v a, b; a.x = cvt_pk_bf16(o1[0], o1[1]); a.y = cvt_pk_bf16(o1[2], o1[3]); b.x = cvt_pk_bf16(o2[0], o2[1]); b.y = cvt_pk_bf16(o2[2], o2[3]);
                    *(u32x2v*)p = a; *(u32x2v*)(p + 32) = b; } }
    }
};
struct EpiGate {
    static constexpr bool PERM = true, AFTER_DRAIN = false;
    bf16_t* O; int ldc; const float* bias;
    __device__ __forceinline__ void operator()(const f32x4 (&acc)[2][2][4][2], const Unit& u, int wr, int wc, int fr, int fq) const {
        const int row0 = u.pm * BM + wr * 64 + fr, col0 = u.pn * BM + wc * 32 + 8 * fq;
        f32x4 bv[2][2];
#pragma unroll
        for (int bj = 0; bj < 2; ++bj)
#pragma unroll
            for (int n = 0; n < 2; ++n) bv[bj][n] = *(const f32x4*)(bias + col0 + bj * HALF + 4 * n);
#pragma unroll
        for (int ai = 0; ai < 2; ++ai)
#pragma unroll
            for (int m = 0; m < 4; ++m) { bf16_t* rowp = O + (size_t)(row0 + ai * HALF + m * 16) * ldc + col0;
#pragma unroll
                for (int bj = 0; bj < 2; ++bj) { const f32x4 v0 = acc[ai][bj][m][0] + bv[bj][0], v1 = acc[ai][bj][m][1] + bv[bj][1];
                    u32x4 w; w.x = cvt_pk_bf16(sigmoidf_fast(v0[0]), sigmoidf_fast(v0[1])); w.y = cvt_pk_bf16(sigmoidf_fast(v0[2]), sigmoidf_fast(v0[3]));
                    w.z = cvt_pk_bf16(sigmoidf_fast(v1[0]), sigmoidf_fast(v1[1])); w.w = cvt_pk_bf16(sigmoidf_fast(v1[2]), sigmoidf_fast(v1[3]));
                    *(u32x4*)(rowp + bj * HALF) = w; } }
    }
};
struct EpiMulInPlace {
    static constexpr bool PERM = true, AFTER_DRAIN = false;
    bf16_t* O; int ldc;
    __device__ __forceinline__ void operator()(const f32x4 (&acc)[2][2][4][2], const Unit& u, int wr, int wc, int fr, int fq) const {
        const int row0 = u.pm * BM + wr * 64 + fr, col0 = u.pn * BM + wc * 32 + 8 * fq;
#pragma unroll
        for (int ai = 0; ai < 2; ++ai)
#pragma unroll
            for (int m = 0; m < 4; ++m) { bf16_t* rowp = O + (size_t)(row0 + ai * HALF + m * 16) * ldc + col0;
#pragma unroll
                for (int bj = 0; bj < 2; ++bj) { const u32x4 g = *(const u32x4*)(rowp + bj * HALF); const f32x4 v0 = acc[ai][bj][m][0], v1 = acc[ai][bj][m][1];
                    u32x4 w; w.x = cvt_pk_bf16(v0[0] * bf_lo(g.x), v0[1] * bf_hi(g.x)); w.y = cvt_pk_bf16(v0[2] * bf_lo(g.y), v0[3] * bf_hi(g.y));
                    w.z = cvt_pk_bf16(v1[0] * bf_lo(g.z), v1[1] * bf_hi(g.z)); w.w = cvt_pk_bf16(v1[2] * bf_lo(g.w), v1[3] * bf_hi(g.w));
                    *(u32x4*)(rowp + bj * HALF) = w; } }
    }
};
struct EpiBranchAcc {
    static constexpr bool PERM = true, AFTER_DRAIN = false;
    bf16_t* O; int ldc; int gcol0; int first;
    __device__ __forceinline__ void operator()(const f32x4 (&acc)[2][2][4][2], const Unit& u, int wr, int wc, int fr, int fq) const {
        const int row0 = u.pm * BM + wr * 64 + fr, col0 = u.pn * BM + wc * 32 + 8 * fq;
#pragma unroll
        for (int ai = 0; ai < 2; ++ai)
#pragma unroll
            for (int m = 0; m < 4; ++m) { bf16_t* rowp = O + (size_t)(row0 + ai * HALF + m * 16) * ldc + col0;
#pragma unroll
                for (int bj = 0; bj < 2; ++bj) { const u32x4 g = *(const u32x4*)(rowp + gcol0 + bj * HALF); const f32x4 v0 = acc[ai][bj][m][0], v1 = acc[ai][bj][m][1];
                    float r[8] = {v0[0] * bf_lo(g.x), v0[1] * bf_hi(g.x), v0[2] * bf_lo(g.y), v0[3] * bf_hi(g.y), v1[0] * bf_lo(g.z), v1[1] * bf_hi(g.z), v1[2] * bf_lo(g.w), v1[3] * bf_hi(g.w)};
                    if (!first) { const u32x4 p = *(const u32x4*)(rowp + bj * HALF);
                        r[0] += bf_lo(p.x); r[1] += bf_hi(p.x); r[2] += bf_lo(p.y); r[3] += bf_hi(p.y); r[4] += bf_lo(p.z); r[5] += bf_hi(p.z); r[6] += bf_lo(p.w); r[7] += bf_hi(p.w); }
                    u32x4 w; w.x = cvt_pk_bf16(r[0], r[1]); w.y = cvt_pk_bf16(r[2], r[3]); w.z = cvt_pk_bf16(r[4], r[5]); w.w = cvt_pk_bf16(r[6], r[7]);
                    *(u32x4*)(rowp + bj * HALF) = w; } }
    }
};

template <class Epi, class Sched, bool ALIGN_EPI = false, bool SP2 = false>
__device__ __forceinline__ void gemm_phase(PG8_LAS unsigned char* lds, const Gemm g, const Sched& S, const Epi& E) {
    const int tid = opaque_tid(), wid = __builtin_amdgcn_readfirstlane(tid >> 6), lane = tid & 63, wr = wid >> 2, wc = wid & 3, fr = lane & 15, fq = lane >> 4;
    const int K = g.K, nt = K / BK, lda = g.lda ? g.lda : g.K;
    unsigned voffA[2], voffB[2];
#pragma unroll
    for (int i = 0; i < 2; ++i) { int R, C; stage_rc(tid * 16 + i * 8192, R, C); const int Rb = Epi::PERM ? ((R & ~31) + perm32(R & 31)) : R;
        voffA[i] = (unsigned)(R * lda + C) * 2u; voffB[i] = (unsigned)(Rb * K + C) * 2u; }
    const size_t kstep = (size_t)(BK * 2);
    const size_t hstepA = (size_t)HALF * lda * 2, tstepA = 2 * hstepA;
    const size_t hstep = (size_t)HALF * K * 2;
    const size_t tstep = 2 * hstep;
    const unsigned ldsw = (unsigned)wid * 1024u;
    const int aoff = lds_byte(wr * 64 + fr, fq * 8), boff = lds_byte(wc * 32 + fr, fq * 8);
#define PG8_SA(b, h) (((b) * 2 + (h)) * HTB)
#define PG8_SB(b, h) ((4 + (b) * 2 + (h)) * HTB)
#define PG8_STAGE(bufoff, gbase, voff) do { _Pragma("unroll") for (int _i = 0; _i < 2; ++_i) \
        __builtin_amdgcn_global_load_lds((const unsigned*)((const char*)(gbase) + (voff)[_i]), (PG8_LAS unsigned*)(lds + (bufoff) + ldsw + _i * 8192), 16, 0, 0); } while (0)
#define PG8_LDA(dst, b, h) do { _Pragma("unroll") for (int m = 0; m < 4; ++m) _Pragma("unroll") for (int k = 0; k < 2; ++k) dst[m][k] = *(const PG8_LAS bf16x8*)(lds + PG8_SA(b, h) + aoff + m * 2048 + k * 1024); } while (0)
#define PG8_LDB(dst, b, h) do { _Pragma("unroll") for (int n = 0; n < 2; ++n) _Pragma("unroll") for (int k = 0; k < 2; ++k) dst[n][k] = *(const PG8_LAS bf16x8*)(lds + PG8_SB(b, h) + boff + n * 2048 + k * 1024); } while (0)
#define PG8_MMA(ai, bj, At, Bt) do { __builtin_amdgcn_s_setprio(1); _Pragma("unroll") for (int m = 0; m < 4; ++m) _Pragma("unroll") for (int n = 0; n < 2; ++n) _Pragma("unroll") for (int k = 0; k < 2; ++k) \
        acc[ai][bj][m][n] = __builtin_amdgcn_mfma_f32_16x16x32_bf16(Bt[n][k], At[m][k], acc[ai][bj][m][n], 0, 0, 0); __builtin_amdgcn_s_setprio(0); } while (0)
#define PG8_WAIT_V(n) asm volatile("s_waitcnt vmcnt(" #n ")" ::: "memory")
#define PG8_WAIT_L(n) asm volatile("s_waitcnt lgkmcnt(" #n ")" ::: "memory")
#define PG8_BAR __builtin_amdgcn_s_barrier()
#define PG8_SCHED __builtin_amdgcn_sched_barrier(0)
    Unit cur, nxt; int ui = 0;
    if (!S.next(0, cur)) return;
    f32x4 acc[2][2][4][2];
#pragma unroll
    for (int a = 0; a < 2; ++a)
#pragma unroll
        for (int b = 0; b < 2; ++b)
#pragma unroll
            for (int m = 0; m < 4; ++m)
#pragma unroll
                for (int n = 0; n < 2; ++n) acc[a][b][m][n] = (f32x4){0.f, 0.f, 0.f, 0.f};
    bf16x8 At[4][2], B0[2][2], B1[2][2];
    const char* cA = (const char*)g.A + (size_t)cur.pm * tstepA + (size_t)(cur.pn / g.adiv) * g.astride; const char* cB = (const char*)g.Bt + (size_t)cur.pn * tstep;
    S.a_ready(cur);
    if constexpr (SP2) {
        PG8_STAGE(PG8_SB(0, 0), cB, voffB); PG8_STAGE(PG8_SB(0, 1), cB + hstep, voffB); PG8_STAGE(PG8_SA(0, 0), cA, voffA); PG8_STAGE(PG8_SA(0, 1), cA + hstepA, voffA);
        if (wr == 1) PG8_BAR;
        PG8_WAIT_V(2); PG8_BAR;
        PG8_STAGE(PG8_SB(1, 0), cB + kstep, voffB); PG8_STAGE(PG8_SA(1, 0), cA + kstep, voffA); PG8_STAGE(PG8_SB(1, 1), cB + hstep + kstep, voffB);
        PG8_WAIT_V(6); PG8_BAR;
    } else {
        PG8_STAGE(PG8_SB(0, 0), cB, voffB); PG8_STAGE(PG8_SA(0, 0), cA, voffA); PG8_STAGE(PG8_SB(0, 1), cB + hstep, voffB); PG8_STAGE(PG8_SA(0, 1), cA + hstepA, voffA);
        if (wr == 1) PG8_BAR;
        PG8_WAIT_V(4); PG8_BAR;
        PG8_STAGE(PG8_SB(1, 0), cB + kstep, voffB); PG8_STAGE(PG8_SA(1, 0), cA + kstep, voffA); PG8_STAGE(PG8_SB(1, 1), cB + hstep + kstep, voffB);
        PG8_WAIT_V(6); PG8_BAR;
    }
    for (;;) {
        const bool has_next = S.next(ui + 1, nxt);
        const char* nA = has_next ? (const char*)g.A + (size_t)nxt.pm * tstepA + (size_t)(nxt.pn / g.adiv) * g.astride : cA; const char* nB = has_next ? (const char*)g.Bt + (size_t)nxt.pn * tstep : cB;
        for (int t = 0; t < nt; t += 2) {
            const bool last = (t == nt - 2);
            const char* a1 = cA + (size_t)(t + 1) * kstep;
            const char* a2 = last ? nA : cA + (size_t)(t + 2) * kstep; const char* b2 = last ? nB : cB + (size_t)(t + 2) * kstep;
            const char* a3 = a2 + kstep; const char* b3 = b2 + kstep;
            if (last && has_next) S.a_ready(nxt);
            if constexpr (SP2) {
            PG8_LDB(B0, 0, 0); PG8_LDB(B1, 0, 1); PG8_SCHED; PG8_LDA(At, 0, 0); PG8_STAGE(PG8_SA(1, 1), a1 + hstepA, voffA);
            PG8_WAIT_V(8); PG8_WAIT_L(0); PG8_BAR; PG8_MMA(0, 0, At, B0); PG8_MMA(0, 1, At, B1); PG8_BAR; PG8_SCHED;
            PG8_LDA(At, 0, 1); PG8_STAGE(PG8_SB(0, 0), b2, voffB); PG8_STAGE(PG8_SB(0, 1), b2 + hstep, voffB); PG8_STAGE(PG8_SA(0, 0), a2, voffA);
            PG8_WAIT_V(8); PG8_WAIT_L(0); PG8_BAR; PG8_MMA(1, 0, At, B0); PG8_MMA(1, 1, At, B1); PG8_BAR; PG8_SCHED;
            PG8_LDB(B0, 1, 0); PG8_LDB(B1, 1, 1); PG8_SCHED; PG8_LDA(At, 1, 0); PG8_STAGE(PG8_SA(0, 1), a2 + hstepA, voffA);
            PG8_WAIT_V(8); PG8_WAIT_L(0); PG8_BAR; PG8_MMA(0, 0, At, B0); PG8_MMA(0, 1, At, B1); PG8_BAR; PG8_SCHED;
            PG8_LDA(At, 1, 1); PG8_STAGE(PG8_SB(1, 0), b3, voffB); PG8_STAGE(PG8_SB(1, 1), b3 + hstep, voffB); PG8_STAGE(PG8_SA(1, 0), a3, voffA);
            PG8_WAIT_V(8); PG8_WAIT_L(0); PG8_BAR; PG8_MMA(1, 0, At, B0); PG8_MMA(1, 1, At, B1); PG8_BAR; PG8_SCHED;
            } else {
            PG8_LDB(B0, 0, 0); PG8_SCHED; PG8_LDA(At, 0, 0); PG8_STAGE(PG8_SA(1, 1), a1 + hstepA, voffA);
            PG8_WAIT_L(8); PG8_BAR; PG8_WAIT_L(0); PG8_MMA(0, 0, At, B0); PG8_BAR; PG8_SCHED;
            PG8_LDB(B1, 0, 1); PG8_STAGE(PG8_SB(0, 0), b2, voffB);
            PG8_BAR; PG8_WAIT_L(0); PG8_MMA(0, 1, At, B1); PG8_BAR;
            PG8_LDA(At, 0, 1); PG8_STAGE(PG8_SA(0, 0), a2, voffA);
            PG8_BAR; PG8_WAIT_L(0); PG8_MMA(1, 0, At, B0); PG8_BAR; PG8_SCHED;
            PG8_STAGE(PG8_SB(0, 1), b2 + hstep, voffB);
            PG8_WAIT_V(6); PG8_BAR; PG8_MMA(1, 1, At, B1); PG8_BAR;
            PG8_LDB(B0, 1, 0); PG8_SCHED; PG8_LDA(At, 1, 0); PG8_STAGE(PG8_SA(0, 1), a2 + hstepA, voffA);
            PG8_WAIT_L(8); PG8_BAR; PG8_WAIT_L(0); PG8_MMA(0, 0, At, B0); PG8_BAR; PG8_SCHED;
            PG8_LDB(B1, 1, 1); PG8_STAGE(PG8_SB(1, 0), b3, voffB);
            PG8_BAR; PG8_WAIT_L(0); PG8_MMA(0, 1, At, B1); PG8_BAR;
            PG8_LDA(At, 1, 1); PG8_STAGE(PG8_SA(1, 0), a3, voffA);
            PG8_BAR; PG8_WAIT_L(0); PG8_MMA(1, 0, At, B0); PG8_BAR; PG8_SCHED;
            PG8_STAGE(PG8_SB(1, 1), b3 + hstep, voffB);
            PG8_WAIT_V(6); PG8_BAR; PG8_MMA(1, 1, At, B1); PG8_BAR;
            }
        }
        if constexpr (ALIGN_EPI) { if (wr == 0) PG8_BAR; }
        if constexpr (!Epi::AFTER_DRAIN) { E(acc, cur, wr, wc, fr, fq); S.done(cur); }
        if (!has_next) break;
#pragma unroll
        for (int a = 0; a < 2; ++a)
#pragma unroll
            for (int b = 0; b < 2; ++b)
#pragma unroll
                for (int m = 0; m < 4; ++m)
#pragma unroll
                    for (int n = 0; n < 2; ++n) acc[a][b][m][n] = (f32x4){0.f, 0.f, 0.f, 0.f};
        cur = nxt; cA = nA; cB = nB; ++ui;
        if constexpr (ALIGN_EPI) { if (wr == 1) PG8_BAR; }
    }
    PG8_WAIT_V(0);
    if constexpr (!ALIGN_EPI) { if (wr == 0) PG8_BAR; }
    PG8_BAR;
    if constexpr (Epi::AFTER_DRAIN) { E.fused(acc, cur, wr, wc, fr, fq, lds, wid, lane); S.done(cur); }
#undef PG8_SA
#undef PG8_SB
#undef PG8_STAGE
#undef PG8_LDA
#undef PG8_LDB
#undef PG8_MMA
#undef PG8_WAIT_V
#undef PG8_WAIT_L
#undef PG8_BAR
#undef PG8_SCHED
}

template <class Epi, class Sched>
__device__ __forceinline__ void gemm_plain(PG8_LAS unsigned char* lds, const Gemm g, const Sched& S, const Epi& E) {
    const int tid = opaque_tid(), wid = __builtin_amdgcn_readfirstlane(tid >> 6), lane = tid & 63, wr = wid >> 2, wc = wid & 3, fr = lane & 15, fq = lane >> 4;
    const int K = g.K, nk = K / 32;
    constexpr int PITCH = 80, TILE = 256 * PITCH;
    const int sr = tid >> 1, sh = tid & 1;
    const int srb = Epi::PERM ? ((sr & ~31) + perm32(sr & 31)) : sr;
    const size_t ga = (size_t)sr * K + sh * 16, gb = (size_t)srb * K + sh * 16;
    const int st = sr * PITCH + sh * 32;
    const int ard = (wr * 64 + fr) * PITCH + fq * 16, brd = (wc * 32 + fr) * PITCH + fq * 16;
    Unit cur;
    for (int ui = 0; S.next(ui, cur); ++ui) {
        const bf16_t* pA = g.A + (size_t)cur.pm * 256 * K + (size_t)(cur.pn / g.adiv) * (g.astride / 2) + ga;
        const bf16_t* pB = g.Bt + (size_t)cur.pn * 256 * K + gb;
        f32x4 acc[2][2][4][2];
#pragma unroll
        for (int a = 0; a < 2; ++a)
#pragma unroll
            for (int b = 0; b < 2; ++b)
#pragma unroll
                for (int m = 0; m < 4; ++m)
#pragma unroll
                    for (int n = 0; n < 2; ++n) acc[a][b][m][n] = (f32x4){0.f, 0.f, 0.f, 0.f};
        u32x4 ra0 = *(const u32x4*)(pA), ra1 = *(const u32x4*)(pA + 8), rb0 = *(const u32x4*)(pB), rb1 = *(const u32x4*)(pB + 8);
        *(PG8_LAS u32x4*)(lds + st) = ra0; *(PG8_LAS u32x4*)(lds + st + 16) = ra1;
        *(PG8_LAS u32x4*)(lds + TILE + st) = rb0; *(PG8_LAS u32x4*)(lds + TILE + st + 16) = rb1;
        __syncthreads();
        for (int kt = 0; kt < nk; ++kt) {
            const int cb = (kt & 1) * 2 * TILE, nb = ((kt + 1) & 1) * 2 * TILE;
            if (kt + 1 < nk) { ra0 = *(const u32x4*)(pA + (kt + 1) * 32); ra1 = *(const u32x4*)(pA + (kt + 1) * 32 + 8); rb0 = *(const u32x4*)(pB + (kt + 1) * 32); rb1 = *(const u32x4*)(pB + (kt + 1) * 32 + 8); }
            bf16x8 Bf[2][2];
#pragma unroll
            for (int bj = 0; bj < 2; ++bj)
#pragma unroll
                for (int n = 0; n < 2; ++n) Bf[bj][n] = *(const PG8_LAS bf16x8*)(lds + cb + TILE + brd + (bj * 128 + n * 16) * PITCH);
#pragma unroll
            for (int ai = 0; ai < 2; ++ai) {
                bf16x8 Af[4];
#pragma unroll
                for (int m = 0; m < 4; ++m) Af[m] = *(const PG8_LAS bf16x8*)(lds + cb + ard + (ai * 128 + m * 16) * PITCH);
#pragma unroll
                for (int bj = 0; bj < 2; ++bj)
#pragma unroll
                    for (int m = 0; m < 4; ++m)
#pragma unroll
                        for (int n = 0; n < 2; ++n) acc[ai][bj][m][n] = __builtin_amdgcn_mfma_f32_16x16x32_bf16(Bf[bj][n], Af[m], acc[ai][bj][m][n], 0, 0, 0);
            }
            if (kt + 1 < nk) { *(PG8_LAS u32x4*)(lds + nb + st) = ra0; *(PG8_LAS u32x4*)(lds + nb + st + 16) = ra1;
                               *(PG8_LAS u32x4*)(lds + nb + TILE + st) = rb0; *(PG8_LAS u32x4*)(lds + nb + TILE + st + 16) = rb1; }
            __syncthreads();
        }
        E(acc, cur, wr, wc, fr, fq);
    }
}
}

namespace att {
using bf16 = unsigned short;
using bf16x8 = __attribute__((ext_vector_type(8))) short;
using s16x4  = __attribute__((ext_vector_type(4))) short;
using f32x16 = __attribute__((ext_vector_type(16))) float;
using u32x4  = __attribute__((ext_vector_type(4))) unsigned;
constexpr int LDQKV = 3840;
constexpr float SCALE = 0.125f;
constexpr float THR = 8.f;
constexpr float NEGBIG = -1e30f;
constexpr float MINIT = -1e9f;
constexpr int OFF_V = 0, OFF_K = 49152, OFF_WS = 98304, OFF_RPB = 98304 + 2048, ATT_LDS = 98304 + 4096;
#define SBAR() __builtin_amdgcn_sched_barrier(0)
__device__ __forceinline__ int crow(int r, int hi) { return (r & 3) + 8 * (r >> 2) + 4 * hi; }
__device__ __forceinline__ constexpr int crow0(int r) { return (r & 3) + 8 * (r >> 2); }
__device__ __forceinline__ unsigned cvtpk(float lo, float hi) { unsigned r; asm volatile("s_nop 0\n\tv_cvt_pk_bf16_f32 %0, %1, %2" : "=v"(r) : "v"(lo), "v"(hi)); return r; }
template <int KW> __device__ __forceinline__ int kswz(int row, int colB) {
  if constexpr (KW == 128) return row * 256 + (colB ^ ((row & 7) << 4));
  else return row * 128 + (colB ^ (((row >> 1) & 7) << 4));
}
struct ModA { int qrow, qc, cs, rs, t0; const float* rpb; __device__ __forceinline__ bool need(int j) const { const int kr = t0 + j; return kr >= rs && kr < rs + 8; } };
struct ModB { int d0, lo, hi; __device__ __forceinline__ bool need(int j) const { return (64 * j + 63 >= lo) && (64 * j <= hi); } };
struct ModC { int dummy; __device__ __forceinline__ constexpr bool need(int) const { return true; } };

template <int MODE, class Mod> __device__ __forceinline__ void modify(f32x16& p0, f32x16& p1, const Mod& md, int j, int hi) {
  if constexpr (MODE == 0) {
    const int kr = md.t0 + j; const bool row_ok = (kr >= md.rs) && (kr < md.rs + 8);
    if (!row_ok) {
#pragma unroll
      for (int r = 0; r < 16; ++r) { p0[r] = NEGBIG; p1[r] = NEGBIG; }
    } else {
      const float* tb = md.rpb + (kr - md.qrow + 7) * 31 + (4 * hi - md.qc + 15);
      const int kc0 = 4 * hi - md.cs;
#pragma unroll
      for (int r = 0; r < 16; ++r) {
        { const float b = tb[crow0(r)];      p0[r] = ((unsigned)(kc0 + crow0(r)) < 16u)      ? p0[r] + b : NEGBIG; }
        { const float b = tb[crow0(r) + 32]; p1[r] = ((unsigned)(kc0 + crow0(r) + 32) < 16u) ? p1[r] + b : NEGBIG; }
      }
    }
  } else if constexpr (MODE == 1) {
    const int base = md.d0 + j * 64 + 128;
#pragma unroll
    for (int r = 0; r < 16; ++r) {
      p0[r] = ((unsigned)(base + crow0(r)) <= 256u) ? p0[r] : NEGBIG;
      p1[r] = ((unsigned)(base + crow0(r) + 32) <= 256u) ? p1[r] : NEGBIG;
    }
  }
}
template <int MODE, class Mod> __device__ __forceinline__ void partialSM(f32x16& p0, f32x16& p1, float& m_reg, float& mn, float& alpha, const Mod& md, int j, int hi) {
  constexpr float C = SCALE * 1.4426950408889634f;
  modify<MODE, Mod>(p0, p1, md, j, hi);
  float pmax = p0[0];
#pragma unroll
  for (int r = 1; r < 16; ++r) pmax = fmaxf(pmax, p0[r]);
#pragma unroll
  for (int r = 0; r < 16; ++r) pmax = fmaxf(pmax, p1[r]);
  { auto rr = __builtin_amdgcn_permlane32_swap(__float_as_uint(pmax), __float_as_uint(pmax), false, false);
    pmax = fmaxf(__uint_as_float(rr[0]), __uint_as_float(rr[1])); }
  if (__builtin_expect(__all(pmax - m_reg <= THR / SCALE), 1)) { mn = m_reg; alpha = 1.f; }
  else { mn = fmaxf(m_reg, pmax); alpha = __builtin_amdgcn_exp2f((m_reg - mn) * C); m_reg = mn; }
  const float mnC = -mn * C;
#pragma unroll
  for (int r = 0; r < 16; ++r) p0[r] = fmaf(p0[r], C, mnC);
#pragma unroll
  for (int r = 0; r < 16; ++r) p1[r] = fmaf(p1[r], C, mnC);
#pragma unroll
  for (int r = 0; r < 16; ++r) p0[r] = __builtin_amdgcn_exp2f(p0[r]);
}
__device__ __forceinline__ void finishSM(f32x16& p0, f32x16& p1, float alpha, float& l_reg, bf16x8& pa0, bf16x8& pa1, bf16x8& pa2, bf16x8& pa3) {
#pragma unroll
  for (int r = 0; r < 16; ++r) p1[r] = __builtin_amdgcn_exp2f(p1[r]);
  float ps = 0;
#pragma unroll
  for (int r = 0; r < 16; ++r) ps += p0[r];
#pragma unroll
  for (int r = 0; r < 16; ++r) ps += p1[r];
  { auto rr = __builtin_amdgcn_permlane32_swap(__float_as_uint(ps), __float_as_uint(ps), false, false);
    ps = __uint_as_float(rr[0]) + __uint_as_float(rr[1]); }
  l_reg = l_reg * alpha + ps;
#define PK4(P, BASE, OUT) do { unsigned a0 = cvtpk(P[BASE + 0], P[BASE + 1]), a1 = cvtpk(P[BASE + 2], P[BASE + 3]);   \
    unsigned b0 = cvtpk(P[BASE + 4], P[BASE + 5]), b1 = cvtpk(P[BASE + 6], P[BASE + 7]);                              \
    auto r0 = __builtin_amdgcn_permlane32_swap(a0, b0, false, false); auto r1 = __builtin_amdgcn_permlane32_swap(a1, b1, false, false); \
    u32x4 w = {r0[0], r1[0], r0[1], r1[1]}; OUT = *reinterpret_cast<bf16x8*>(&w); } while (0)
  PK4(p0, 0, pa0); PK4(p0, 8, pa1); PK4(p1, 0, pa2); PK4(p1, 8, pa3);
#undef PK4
}
template <int KW> __device__ __forceinline__ void qkt(f32x16& p0, f32x16& p1, const char* Ks, const bf16x8 (&qr)[4], int r32, int hi, int kcolB) {
  p0 = f32x16{}; p1 = f32x16{};
#pragma unroll
  for (int d0 = 0; d0 < 4; ++d0) { const int cb = kcolB + (d0 * 16 + hi * 8) * 2;
    const bf16x8 b0 = *reinterpret_cast<const bf16x8*>(Ks + kswz<KW>(r32, cb));
    const bf16x8 b1 = *reinterpret_cast<const bf16x8*>(Ks + kswz<KW>(32 + r32, cb));
    p0 = __builtin_amdgcn_mfma_f32_32x32x16_bf16(b0, qr[d0], p0, 0, 0, 0);
    p1 = __builtin_amdgcn_mfma_f32_32x32x16_bf16(b1, qr[d0], p1, 0, 0, 0); }
}
template <int DV> __device__ __forceinline__ int v_st(int k, int c) { const int kk = (k & ~0xC) | ((k & 4) << 1) | ((k & 8) >> 1); return ((kk >> 3) * (DV / 32) + (c >> 5)) * 512 + ((kk & 7) * 32 + (c & 31)) * 2; }
__device__ __forceinline__ int v_rd_base(int lane) { return ((lane & 3) << 3) | (((lane >> 2) & 3) << 6) | (((lane >> 4) & 1) << 5) | (((lane >> 5) & 1) << 8); }
template <int DV> constexpr int v_rd_off(int d0, int ks, int half) { return d0 * 512 + ks * (DV / 32) * 1024 + half * (DV / 32) * 512; }
template <int OFF> __device__ __forceinline__ s16x4 tr_read(int vb) {
  s16x4 r; asm volatile("ds_read_b64_tr_b16 %0, %1 offset:%2" : "=&v"(r) : "v"(vb), "i"(OFF) : "memory"); return r;
}
template <int DV, int D0> __device__ __forceinline__ void pv_one(f32x16& od, int vb, bf16x8 pa0, bf16x8 pa1, bf16x8 pa2, bf16x8 pa3) {
  const s16x4 l0 = tr_read<v_rd_off<DV>(D0, 0, 0)>(vb), h0 = tr_read<v_rd_off<DV>(D0, 0, 1)>(vb), l1 = tr_read<v_rd_off<DV>(D0, 1, 0)>(vb), h1 = tr_read<v_rd_off<DV>(D0, 1, 1)>(vb);
  const s16x4 l2 = tr_read<v_rd_off<DV>(D0, 2, 0)>(vb), h2 = tr_read<v_rd_off<DV>(D0, 2, 1)>(vb), l3 = tr_read<v_rd_off<DV>(D0, 3, 0)>(vb), h3 = tr_read<v_rd_off<DV>(D0, 3, 1)>(vb);
  asm volatile("s_waitcnt lgkmcnt(0)" ::: "memory"); SBAR();
#define PK(L, H) (bf16x8){L[0], L[1], L[2], L[3], H[0], H[1], H[2], H[3]}
  od = __builtin_amdgcn_mfma_f32_32x32x16_bf16(pa0, PK(l0, h0), od, 0, 0, 0);
  od = __builtin_amdgcn_mfma_f32_32x32x16_bf16(pa1, PK(l1, h1), od, 0, 0, 0);
  od = __builtin_amdgcn_mfma_f32_32x32x16_bf16(pa2, PK(l2, h2), od, 0, 0, 0);
  od = __builtin_amdgcn_mfma_f32_32x32x16_bf16(pa3, PK(l3, h3), od, 0, 0, 0);
#undef PK
}
template <int DV> __device__ __forceinline__ void pv_all(f32x16 (&o)[DV / 32], int vb, bf16x8 pa0, bf16x8 pa1, bf16x8 pa2, bf16x8 pa3) {
  pv_one<DV, 0>(o[0], vb, pa0, pa1, pa2, pa3); pv_one<DV, 1>(o[1], vb, pa0, pa1, pa2, pa3);
  if constexpr (DV == 128) { pv_one<DV, 2>(o[2], vb, pa0, pa1, pa2, pa3); pv_one<DV, 3>(o[3], vb, pa0, pa1, pa2, pa3); }
}

template <int KW, int DV, int MODE, class Mod>
__device__ __forceinline__ void attn_loop(const bf16* __restrict__ Qw, const bf16* __restrict__ Kt, const bf16* __restrict__ Vt, int NT, int kcolB, char* lds, const Mod& md,
                                          f32x16 (&o)[DV / 32], float& m_reg, float& l_reg) {
  constexpr int SHM_V = 64 * DV * 2, SHM_K = 64 * KW * 2, NKL = KW / 64, NVL = DV / 64;
  const int tid = opaque_tid(), wid = tid >> 6, lane = tid & 63, r32 = lane & 31, hi = lane >> 5;
  char* V_lds = lds + OFF_V; char* K_lds = lds + OFF_K;
  float* al_l = (float*)(lds + OFF_WS) + wid * 64 + 32;
  m_reg = MINIT; l_reg = 0.f;
#pragma unroll
  for (int d = 0; d < DV / 32; ++d) o[d] = f32x16{};
  bf16x8 qr[4];
#pragma unroll
  for (int d0 = 0; d0 < 4; ++d0) qr[d0] = *reinterpret_cast<const bf16x8*>(Qw + d0 * 16);
  const int ksr = (KW == 128) ? (tid >> 4) : (tid >> 3), ksc = (KW == 128) ? (tid & 15) * 8 : (tid & 7) * 8;
  const int vsr = (DV == 128) ? (tid >> 4) : (tid >> 3), vsc = (DV == 128) ? (tid & 15) * 8 : (tid & 7) * 8;
  const int vst0 = v_st<DV>(vsr, vsc), vst1 = v_st<DV>(32 + vsr, vsc);
  const int kst0 = kswz<KW>(ksr, ksc * 2), kst1 = kswz<KW>(32 + ksr, ksc * 2);
  const int vb0 = (int)(uintptr_t)V_lds + v_rd_base(lane);
  const bf16* Kp = Kt + (long)ksr * LDQKV + ksc; const bf16* Vp = Vt + (long)vsr * LDQKV + vsc;
  bf16x8 sK[NKL], sV[NVL];
#define SLOAD(k0) do { _Pragma("unroll") for (int q_ = 0; q_ < NVL; ++q_) sV[q_] = *reinterpret_cast<const bf16x8*>(Vp + (long)((k0) + 32 * q_) * LDQKV); \
    _Pragma("unroll") for (int q_ = 0; q_ < NKL; ++q_) sK[q_] = *reinterpret_cast<const bf16x8*>(Kp + (long)((k0) + 32 * q_) * LDQKV); } while (0)
#define SWRITE(b) do { *(bf16x8*)(V_lds + (b) * SHM_V + vst0) = sV[0]; if constexpr (NVL == 2) *(bf16x8*)(V_lds + (b) * SHM_V + vst1) = sV[NVL - 1]; \
    *(bf16x8*)(K_lds + (b) * SHM_K + kst0) = sK[0]; if constexpr (NKL == 2) *(bf16x8*)(K_lds + (b) * SHM_K + kst1) = sK[NKL - 1]; } while (0)
#define RESC(a) do { if (__any((a) < 1.f)) { if (hi == 0) al_l[r32] = (a); asm volatile("s_waitcnt lgkmcnt(0)" ::: "memory"); \
    _Pragma("unroll") for (int d = 0; d < DV / 32; ++d) _Pragma("unroll") for (int r = 0; r < 16; ++r) o[d][r] *= al_l[crow(r, hi)]; } } while (0)
  f32x16 pA0, pA1, pB0, pB1; float mnA, mnB, alA, alB; bf16x8 pa0, pa1, pa2, pa3;
  SLOAD(0); SWRITE(0); SLOAD(64);
  __syncthreads();
  if (md.need(0)) { qkt<KW>(pA0, pA1, K_lds, qr, r32, hi, kcolB); partialSM<MODE, Mod>(pA0, pA1, m_reg, mnA, alA, md, 0, hi); } else alA = 1.f;
  int b0 = 0, b1 = 1;
  for (int j = 1; j + 1 < NT; j += 2) {
    const bool n0 = md.need(j - 1), n1 = md.need(j), n2 = md.need(j + 1);
    const int b2 = (b1 == 2) ? 0 : b1 + 1;
    SWRITE(b1); SBAR(); SLOAD((j + 1) * 64); SBAR();
    __syncthreads();
    if (n1) qkt<KW>(pB0, pB1, K_lds + b1 * SHM_K, qr, r32, hi, kcolB);
    if (n0) finishSM(pA0, pA1, alA, l_reg, pa0, pa1, pa2, pa3); SBAR();
    if (n0) pv_all<DV>(o, vb0 + b0 * SHM_V, pa0, pa1, pa2, pa3); if (n1) partialSM<MODE, Mod>(pB0, pB1, m_reg, mnB, alB, md, j, hi); else alB = 1.f;
    RESC(alB);
    SBAR(); SWRITE(b2); SBAR(); if (j + 2 < NT) SLOAD((j + 2) * 64); SBAR();
    __syncthreads();
    if (n2) qkt<KW>(pA0, pA1, K_lds + b2 * SHM_K, qr, r32, hi, kcolB);
    if (n1) finishSM(pB0, pB1, alB, l_reg, pa0, pa1, pa2, pa3); SBAR();
    if (n1) pv_all<DV>(o, vb0 + b1 * SHM_V, pa0, pa1, pa2, pa3); if (n2) partialSM<MODE, Mod>(pA0, pA1, m_reg, mnA, alA, md, j + 1, hi); else alA = 1.f;
    RESC(alA);
    b0 = b2; b1 = (b2 == 2) ? 0 : b2 + 1;
  }
  { const bool t0_ = md.need(NT - 2), t1_ = md.need(NT - 1);
    SBAR(); SWRITE(b1); SBAR();
    __syncthreads();
    if (t1_) qkt<KW>(pB0, pB1, K_lds + b1 * SHM_K, qr, r32, hi, kcolB);
    if (t0_) finishSM(pA0, pA1, alA, l_reg, pa0, pa1, pa2, pa3); SBAR();
    if (t0_) pv_all<DV>(o, vb0 + b0 * SHM_V, pa0, pa1, pa2, pa3); if (t1_) partialSM<MODE, Mod>(pB0, pB1, m_reg, mnB, alB, md, NT - 1, hi); else alB = 1.f;
    RESC(alB);
    if (t1_) { finishSM(pB0, pB1, alB, l_reg, pa0, pa1, pa2, pa3); SBAR();
      pv_all<DV>(o, vb0 + b1 * SHM_V, pa0, pa1, pa2, pa3); } }
#undef SLOAD
#undef SWRITE
#undef RESC
}
}

typedef unsigned short bf16;
typedef float f32x4 __attribute__((ext_vector_type(4)));
typedef unsigned v4u __attribute__((ext_vector_type(4)));
typedef unsigned v2u __attribute__((ext_vector_type(2)));
constexpr int NWAVES = 8;
constexpr int NB = 4, S = 8192, D = 1024, FF = 2816, M = NB * S, DEPTH = 2;
constexpr int NQKV = 3840, NGATE = 3072, INCOLS = 6912;
constexpr float EPS = 1e-6f;
constexpr size_t MiB = 1u << 20;
constexpr size_t WS_WGU1 = 0, WS_WD1 = 11 * MiB, WS_WQKV = 16 * MiB + MiB / 2, WS_WGATE = 24 * MiB, WS_WBR = 30 * MiB, WS_WOUT = 33 * MiB, WS_WGU2 = 35 * MiB, WS_WD2 = 46 * MiB;
constexpr size_t WS_ROPE = 56 * MiB;
constexpr size_t WS_XN = 58 * MiB;
constexpr size_t WS_BIG = 122 * MiB;
constexpr size_t WS_Y = WS_BIG + 192 * MiB;
constexpr size_t WS_OATT = WS_BIG + 240 * MiB;
constexpr size_t WS_CTL = WS_OATT + 96 * MiB;
constexpr size_t WS_L1W = 459 * MiB;
constexpr size_t WS_END = WS_L1W + 52 * MiB;
constexpr int BIGP = 3840;
constexpr int LDS_BYTES = 135168;

__device__ __forceinline__ float wave_sum(float v) {
#pragma unroll
    for (int o = 1; o < 64; o <<= 1) v += __shfl_xor(v, o);
    return v;
}
__device__ __forceinline__ unsigned pk2(float lo, float hi) { return pg8::cvt_pk_bf16(lo, hi); }

template <int MAP> __device__ __forceinline__ int rowmap(int c) {
    if constexpr (MAP == 1) { return c < FF ? ((c >> 7) * 256 + (c & 127)) : ((((c - FF) >> 7) * 256) + 128 + ((c - FF) & 127)); }
    else if constexpr (MAP == 2) { const int head = c >> 6, d = c & 63, hi = d >> 5, dd = d & 31, w2 = dd >> 4, j = dd & 15; return head * 64 + w2 * 32 + hi * 16 + j; }
    else return c;
}
template <int MAP> __device__ __forceinline__ void transpose_item(const float* __restrict__ W, int ldn, int ncol0, int nblk, bf16* __restrict__ WT, int ldk, int koff, int row_off, float* scr, int item, int lane, int ncopies) {
    const int kb = item / nblk, nb = item % nblk, k0 = 64 * kb, n0 = 32 * nb;
    float wv[32];
#pragma unroll
    for (int i = 0; i < 32; ++i) wv[i] = W[(size_t)(k0 + 2 * i + (lane >> 5)) * ldn + ncol0 + n0 + (lane & 31)];
#pragma unroll
    for (int i = 0; i < 32; ++i) scr[(2 * i + (lane >> 5)) * 33 + (lane & 31)] = wv[i];
    asm volatile("s_waitcnt lgkmcnt(0)" ::: "memory");
    const int c = lane & 7;
#pragma unroll
    for (int j = 0; j < 4; ++j) { const int n = (lane >> 3) + 8 * j; const float* s = scr + (8 * c) * 33 + n;
        v4u o; o.x = pk2(s[0 * 33], s[1 * 33]); o.y = pk2(s[2 * 33], s[3 * 33]); o.z = pk2(s[4 * 33], s[5 * 33]); o.w = pk2(s[6 * 33], s[7 * 33]);
        bf16* dst = WT + (size_t)(row_off + rowmap<MAP>(n0 + n)) * ldk + koff + k0 + 8 * c;
        for (int cp = 0; cp < ncopies; ++cp) *(v4u*)(dst + (size_t)cp * 1024) = o; }
    asm volatile("s_waitcnt lgkmcnt(0)" ::: "memory");
}

struct Args {
    unsigned long long in[22];
    unsigned long long out, ws;
    int step_lo, step_hi;
};
typedef const __attribute__((address_space(4))) Args* KArgP;
#define AIN(a, i) ((const float*)(GASQ const float*)((a)->in[i]))
#define AOUT(a) ((float*)(GASQ float*)((a)->out))
#define AWS(a) ((unsigned char*)(GASQ unsigned char*)((a)->ws))

__device__ __forceinline__ void convert_weights(KArgP a, int l, float* scr, int gw, int NGW, int lane) {
    unsigned char* ws = AWS(a) + (l ? WS_L1W : 0);
    const float* gu1 = AIN(a, 2) + (size_t)l * D * 2 * FF; const float* d1 = AIN(a, 3) + (size_t)l * FF * D;
    const float* win = AIN(a, 6) + (size_t)l * D * INCOLS; const float* wbr = AIN(a, 14) + (size_t)l * 3 * 512 * D; const float* wout = AIN(a, 16) + (size_t)l * D * D;
    const float* gu2 = AIN(a, 19) + (size_t)l * D * 2 * FF; const float* d2 = AIN(a, 20) + (size_t)l * FF * D;
    constexpr int I_GU = (D / 64) * (2 * FF / 32), I_D = (FF / 64) * (D / 32), I_QKV = (D / 64) * (NQKV / 32), I_G = (D / 64) * (NGATE / 32), I_BR = (512 / 64) * (D / 32), I_O = (D / 64) * (D / 32);
    constexpr int NITEMS = 2 * I_GU + 2 * I_D + I_QKV + I_G + 3 * I_BR + I_O;
    for (int it = gw; it < NITEMS; it += NGW) {
        int r = it;
        if (r < I_GU) { transpose_item<1>(gu1, 2 * FF, 0, 2 * FF / 32, (bf16*)(ws + WS_WGU1), D, 0, 0, scr, r, lane, 1); continue; } r -= I_GU;
        if (r < I_GU) { transpose_item<1>(gu2, 2 * FF, 0, 2 * FF / 32, (bf16*)(ws + WS_WGU2), D, 0, 0, scr, r, lane, 1); continue; } r -= I_GU;
        if (r < I_D) { transpose_item<0>(d1, D, 0, D / 32, (bf16*)(ws + WS_WD1), FF, 0, 0, scr, r, lane, 1); continue; } r -= I_D;
        if (r < I_D) { transpose_item<0>(d2, D, 0, D / 32, (bf16*)(ws + WS_WD2), FF, 0, 0, scr, r, lane, 1); continue; } r -= I_D;
        if (r < I_QKV) { transpose_item<2>(win, INCOLS, 0, NQKV / 32, (bf16*)(ws + WS_WQKV), D, 0, 0, scr, r, lane, 1); continue; } r -= I_QKV;
        if (r < I_G) { transpose_item<0>(win, INCOLS, NQKV, NGATE / 32, (bf16*)(ws + WS_WGATE), D, 0, 0, scr, r, lane, 1); continue; } r -= I_G;
        if (r < 3 * I_BR) { const int br = r / I_BR; transpose_item<0>(wbr + (size_t)br * 512 * D, D, 0, D / 32, (bf16*)(ws + WS_WBR), 512, 0, br * D, scr, r % I_BR, lane, 1); continue; } r -= 3 * I_BR;
        transpose_item<0>(wout, D, 0, D / 32, (bf16*)(ws + WS_WOUT), D, 0, 0, scr, r, lane, 1);
    }
}

__device__ __forceinline__ void row_phase(const float* hin, float* hout, const float* Y, const float* gpost, float coef,
                                          const float* gnext, bf16* XN, int gw, int NGW, int lane) {
    f32x4 gp[4], gn[4];
#pragma unroll
    for (int j = 0; j < 4; ++j) { gp[j] = Y ? *((const f32x4*)gpost + lane + 64 * j) : (f32x4){0.f, 0.f, 0.f, 0.f}; gn[j] = gnext ? *((const f32x4*)gnext + lane + 64 * j) : (f32x4){0.f, 0.f, 0.f, 0.f}; }
    for (int t_ = 0; t_ < 8; ++t_) {
        int m[2];
#pragma unroll
        for (int q = 0; q < 2; ++q) { const int tt = t_ + 8 * q;
            m[q] = (NGW < 0) ? ((((q == 0) ? (gw >> 16) : (gw >> 16) + 8) << 8) + (gw & 0xffff) + t_) : (gw + tt * NGW); }
        f32x4 v[2][4]; v2u yw[2][4];
#pragma unroll
        for (int q = 0; q < 2; ++q) { const int mm = m[q] < M ? m[q] : 0;
            const f32x4* hr = (const f32x4*)(hin + (size_t)mm * D) + lane;
#pragma unroll
            for (int j = 0; j < 4; ++j) v[q][j] = hr[64 * j];
            if (Y) { const v2u* yr = (const v2u*)((const bf16*)Y + (size_t)mm * D) + lane;
#pragma unroll
                for (int j = 0; j < 4; ++j) yw[q][j] = yr[64 * j]; } }
#pragma unroll
        for (int q = 0; q < 2; ++q) {
            if (m[q] >= M) continue;
            if (Y) {
                f32x4 y[4]; float s = 0.f;
#pragma unroll
                for (int j = 0; j < 4; ++j) { const v2u w = yw[q][j]; y[j] = (f32x4){pg8::bf_lo(w.x), pg8::bf_hi(w.x), pg8::bf_lo(w.y), pg8::bf_hi(w.y)}; s += (y[j].x * y[j].x + y[j].y * y[j].y) + (y[j].z * y[j].z + y[j].w * y[j].w); }
                const float r = coef * __builtin_amdgcn_rsqf(wave_sum(s) * (1.f / D) + EPS);
#pragma unroll
                for (int j = 0; j < 4; ++j) v[q][j] = v[q][j] + y[j] * gp[j] * r;
                f32x4* ho = (f32x4*)(hout + (size_t)m[q] * D) + lane;
#pragma unroll
                for (int j = 0; j < 4; ++j) ho[64 * j] = v[q][j];
            }
            if (gnext) {
                float s2 = 0.f;
#pragma unroll
                for (int j = 0; j < 4; ++j) s2 += (v[q][j].x * v[q][j].x + v[q][j].y * v[q][j].y) + (v[q][j].z * v[q][j].z + v[q][j].w * v[q][j].w);
                const float r2 = __builtin_amdgcn_rsqf(wave_sum(s2) * (1.f / D) + EPS);
                unsigned long long* o8 = (unsigned long long*)(XN + (size_t)m[q] * D) + lane;
#pragma unroll
                for (int j = 0; j < 4; ++j) { const f32x4 t = v[q][j] * gn[j] * r2;
                    o8[64 * j] = (unsigned long long)pk2(t.x, t.y) | ((unsigned long long)pk2(t.z, t.w) << 32); }
            }
        }
    }
}

#ifndef ATTMASK
#define ATTMASK 7
#endif
template <int AMODE> __device__ __forceinline__ void attention_phase(KArgP a, int l, char* lds, int vcu, int G) {
    using namespace att;
    const int tid = opaque_tid(), wid = tid >> 6, lane = tid & 63, r32 = lane & 31, hi = lane >> 5;
    const bf16* QKV = (const bf16*)(AWS(a) + WS_BIG);
    bf16* OA = (bf16*)(AWS(a) + WS_OATT); bf16* OB = OA + (size_t)M * 512; bf16* OC = OB + (size_t)M * 512;
    float* wsf = (float*)(lds + OFF_WS) + wid * 64;
    float lam = 0.f, lam_init = 0.f;
    if constexpr (AMODE == 0) { const float q1 = AIN(a, 9)[l * 64 + lane], k1 = AIN(a, 10)[l * 64 + lane], q2 = AIN(a, 11)[l * 64 + lane], k2 = AIN(a, 12)[l * 64 + lane];
      lam_init = 0.8f - 0.6f * __expf(-0.3f * (float)l);
      lam = __expf(wave_sum(q1 * k1)) - __expf(wave_sum(q2 * k2)) + lam_init; }
    if constexpr (AMODE == 0)
    for (int u = vcu; u < 1024; u += G) {
        const int bh = u >> 6, qb = u & 63, b = bh >> 2, h = bh & 3, t = wid >> 2;
        const long tok0 = (long)b * S + qb * 128;
        const bf16* Qw = QKV + (tok0 + (wid & 3) * 32 + r32) * LDQKV + 2304 + h * 128 + t * 64 + hi * 8;
        const bf16* Kt = QKV + (long)b * S * LDQKV + 2816 + h * 128;
        const bf16* Vt = QKV + (long)b * S * LDQKV + 3328 + h * 128;
        f32x16 o[4]; float m_reg, l_reg; ModC md{0};
        attn_loop<128, 128, 2, ModC>(Qw, Kt, Vt, S / 64, t * 128, lds, md, o, m_reg, l_reg);
        if (hi == 0) wsf[r32] = l_reg;
        asm volatile("s_waitcnt lgkmcnt(0)" ::: "memory");
        float rli[16];
#pragma unroll
        for (int r = 0; r < 16; ++r) rli[r] = __builtin_amdgcn_rcpf(wsf[crow(r, hi)]);
        __syncthreads();
        float* ex = (float*)lds + ((wid & 3) * 64) * 64 + lane;
        if (t == 1) {
#pragma unroll
            for (int d0 = 0; d0 < 4; ++d0)
#pragma unroll
                for (int r = 0; r < 16; ++r) ex[(d0 * 16 + r) * 64] = o[d0][r] * rli[r];
        }
        __syncthreads();
        if (t == 0) {
            const float* gsub = AIN(a, 13) + l * 128;
            float gg[4];
#pragma unroll
            for (int d0 = 0; d0 < 4; ++d0) gg[d0] = gsub[d0 * 32 + r32] * (1.0f - lam_init);
#pragma unroll
            for (int r = 0; r < 16; ++r) {
                float dv[4]; float ss = 0.f;
#pragma unroll
                for (int d0 = 0; d0 < 4; ++d0) { dv[d0] = o[d0][r] * rli[r] - lam * ex[(d0 * 16 + r) * 64]; ss += dv[d0] * dv[d0]; }
                ss += __shfl_xor(ss, 1); ss += __shfl_xor(ss, 2); ss += __shfl_xor(ss, 4); ss += __shfl_xor(ss, 8); ss += __shfl_xor(ss, 16);
                const float rn = __builtin_amdgcn_rsqf(ss * (1.f / 128.f) + EPS);
                bf16* op = OC + (tok0 + (wid & 3) * 32 + crow(r, hi)) * 512 + h * 128 + r32;
#pragma unroll
                for (int d0 = 0; d0 < 4; ++d0) op[d0 * 32] = (bf16)(pk2(dv[d0] * rn * gg[d0], 0.f) & 0xffffu);
            }
        }
        __syncthreads();
    }
    if constexpr (AMODE == 1)
    for (int u = vcu; u < 1024; u += G) {
        const int bh = u >> 5, qb = u & 31, b = bh >> 3, h = bh & 7;
        const long tok0 = (long)b * S + qb * 256;
        const int t0 = (4 * qb - 4) < 0 ? 0 : (4 * qb - 4), t1 = (4 * qb + 8) > 128 ? 128 : (4 * qb + 8);
        { const float* rp = AIN(a, 7) + ((size_t)l * 8 + h) * 465; float* tb = (float*)(lds + OFF_RPB); if (tid < 465) tb[tid] = rp[tid] * 8.0f; }
        const int qtok = qb * 256 + wid * 32 + r32;
        ModA md; md.qrow = qtok >> 6; md.qc = qtok & 63; md.cs = (md.qc - 8) < 0 ? 0 : ((md.qc - 8) > 48 ? 48 : (md.qc - 8)); md.rs = (md.qrow - 4) < 0 ? 0 : ((md.qrow - 4) > 120 ? 120 : (md.qrow - 4));
        md.rs = __builtin_amdgcn_readfirstlane(md.rs); md.t0 = t0; md.rpb = (const float*)(lds + OFF_RPB);
        const bf16* Qw = QKV + (tok0 + wid * 32 + r32) * LDQKV + 0 + h * 64 + hi * 8;
        const bf16* Kt = QKV + ((long)b * S + t0 * 64) * LDQKV + 512 + h * 64;
        const bf16* Vt = QKV + ((long)b * S + t0 * 64) * LDQKV + 1024 + h * 64;
        f32x16 o[2]; float m_reg, l_reg;
        attn_loop<64, 64, 0, ModA>(Qw, Kt, Vt, t1 - t0, 0, lds, md, o, m_reg, l_reg);
        if (hi == 0) wsf[r32] = l_reg;
        asm volatile("s_waitcnt lgkmcnt(0)" ::: "memory");
#pragma unroll
        for (int r = 0; r < 16; ++r) { const float rl = __builtin_amdgcn_rcpf(wsf[crow(r, hi)]);
            bf16* op = OA + (tok0 + wid * 32 + crow(r, hi)) * 512 + h * 64 + r32;
#pragma unroll
            for (int d0 = 0; d0 < 2; ++d0) op[d0 * 32] = (bf16)(pk2(o[d0][r] * rl, 0.f) & 0xffffu); }
        __syncthreads();
    }
    if constexpr (AMODE == 2)
    for (int u = vcu; u < 1024; u += G) {
        const int bh = u >> 5, qb = u & 31, b = bh >> 3, h = bh & 7, kvh = h >> 2;
        const long tok0 = (long)b * S + qb * 256;
        const int k0 = (qb * 256 - 128) < 0 ? 0 : (qb * 256 - 128), k1 = (qb * 256 + 384) > S ? S : (qb * 256 + 384);
        ModB md; md.d0 = k0 - (qb * 256 + wid * 32 + r32) + 4 * hi;
        { const int qmin = qb * 256 + __builtin_amdgcn_readfirstlane(wid) * 32; md.lo = qmin - 128 - k0; md.hi = qmin + 31 + 128 - k0; }
        const bf16* Qw = QKV + (tok0 + wid * 32 + r32) * LDQKV + 1536 + h * 64 + hi * 8;
        const bf16* Kt = QKV + ((long)b * S + k0) * LDQKV + 2048 + kvh * 64;
        const bf16* Vt = QKV + ((long)b * S + k0) * LDQKV + 2176 + kvh * 64;
        f32x16 o[2]; float m_reg, l_reg;
        attn_loop<64, 64, 1, ModB>(Qw, Kt, Vt, (k1 - k0) / 64, 0, lds, md, o, m_reg, l_reg);
        l_reg += __expf(AIN(a, 8)[l * 8 + h] - SCALE * m_reg);
        if (hi == 0) wsf[r32] = l_reg;
        asm volatile("s_waitcnt lgkmcnt(0)" ::: "memory");
#pragma unroll
        for (int r = 0; r < 16; ++r) { const float rl = __builtin_amdgcn_rcpf(wsf[crow(r, hi)]);
            bf16* op = OB + (tok0 + wid * 32 + crow(r, hi)) * 512 + h * 64 + r32;
#pragma unroll
            for (int d0 = 0; d0 < 2; ++d0) op[d0 * 32] = (bf16)(pk2(o[d0][r] * rl, 0.f) & 0xffffu); }
        __syncthreads();
    }
}

#ifndef PHMASK
#define PHMASK 0xffff
#endif
#define PH(b) if constexpr ((PHMASK >> (b)) & 1)
template <int KIND>
__global__ void __launch_bounds__(NWAVES * 64, 2) fwd_megakernel(Args a_unused) {
    constexpr bool ALL = KIND < 0;
    extern __shared__ __attribute__((aligned(16))) unsigned char lds[];
    cg::grid_group grid = cg::this_grid();
    KArgP ap0 = (KArgP)__builtin_amdgcn_kernarg_segment_ptr();
#define ARGS() ({ KArgP p_ = ap0; asm volatile("" : "+s"(p_)); p_; })
    const int G0 = gridDim.x, bx0 = blockIdx.x;
    PG8_LAS unsigned char* ldsL = (PG8_LAS unsigned char*)lds;

    const int step_lo = ARGS()->step_lo, step_hi = ARGS()->step_hi;
    if ((ALL || KIND == 9) && step_lo < 0) {
        KArgP a = ARGS(); const int G = G0, bx = bx0;
        const int tid = threadIdx.x, lane = tid & 63, wave = __builtin_amdgcn_readfirstlane(tid >> 6);
        const int gw = bx * NWAVES + wave, NGW = G * NWAVES;
        float* scr = (float*)lds + wave * (64 * 33);
        float* cosT = (float*)(AWS(a) + WS_ROPE); float* sinT = cosT + 8192 * 32;
        if (bx == 0 && tid < 64) { ((unsigned*)(AWS(a) + WS_CTL))[tid * 64] = 0u; ((unsigned*)(AWS(a) + WS_CTL))[tid * 64 + 1] = 0u; }
        PH(0) { convert_weights(a, 0, scr, gw, NGW, lane); convert_weights(a, 1, scr, gw, NGW, lane); }
        for (int i = bx * 512 + tid; i < 8192 * 32; i += G * 512) { const int pos = i >> 5, d = i & 31; const float inv = exp2f(-(float)d * (13.287712379549449f / 32.0f)); const float ang = (float)pos * inv; float sn, cs; sincosf(ang, &sn, &cs); cosT[i] = cs; sinT[i] = sn; }
        PH(1) row_phase(AIN(a, 0), nullptr, nullptr, nullptr, 0.f, AIN(a, 1), (bf16*)(AWS(a) + WS_XN), gw, NGW, lane);
        __syncthreads();
        if (step_hi > 0) gsync(grid);
    }

    constexpr int NS = 14;
    unsigned gtarget = 0u, gsame = 0u;
#ifndef MAXSTEP
#define MAXSTEP (14 * DEPTH)
#endif
    for (int step = (step_lo < 0 ? 0 : step_lo); step < step_hi; ++step) {
#ifdef DBG_DUMP
        if ((ALL || KIND == 10) && step == MAXSTEP) {
            KArgP a = ARGS(); float* o = AOUT(a); const bf16* src = (const bf16*)(AWS(a) + (size_t)DBG_DUMP_MIB * MiB);
            const unsigned t0_ = (unsigned)bx0 * 512u + (unsigned)opaque_tid();
#pragma nounroll
            for (unsigned i = t0_; i < (unsigned)(M * D); i += (unsigned)G0 * 512u) {
                float v = (DBG_DUMP_N == 0) ? ((const float*)src)[i] : ((i < (unsigned)DBG_DUMP_LIMIT) ? __uint_as_float((unsigned)src[i] << 16) : 0.f);
                if (DBG_DUMP_N > 1) v += __uint_as_float((unsigned)src[(size_t)i + DBG_DUMP_STRIDE] << 16);
                if (DBG_DUMP_N > 2) v += __uint_as_float((unsigned)src[(size_t)i + 2 * DBG_DUMP_STRIDE] << 16);
                o[i] = v; }
            break;
        }
#endif
        const int l = step / NS, sidx = step % NS;
        const int G = opaque_s(G0), bx = opaque_s(bx0);
        const bool grp = (G == 256);
        if (step == 0 && grp && threadIdx.x == 0)
            __hip_atomic_fetch_or((unsigned*)(AWS(ARGS()) + WS_CTL) + (((bx & 7) * 8 + ((bx >> 3) & 7)) * 64) + 1, 1u << ((unsigned)__builtin_amdgcn_s_getreg((3 << 11) | 20) & 0xFu), __ATOMIC_RELAXED, __HIP_MEMORY_SCOPE_AGENT);
        KArgP a = ARGS();
        unsigned char* ws = AWS(a); unsigned char* wsw = ws + (l ? WS_L1W : 0);
        bf16* XN = (bf16*)(ws + WS_XN); bf16* BIG = (bf16*)(ws + WS_BIG); float* Y = (float*)(ws + WS_Y);
        if ((ALL || KIND == 0) && (sidx == 0 || sidx == 11)) {
            PH(2) { pg8::Gemm g{XN, (const bf16*)(wsw + (sidx == 0 ? WS_WGU1 : WS_WGU2)), M, 2 * FF, D, 1 << 30, 0}; pg8::StaticOrder So; So.init(M, 2 * FF, G, bx);
              pg8::EpiSwiGLU E{BIG, BIGP}; pg8::gemm_phase<pg8::EpiSwiGLU, pg8::StaticOrder, true, true>(ldsL, g, So, E); }
        } else if ((ALL || KIND == 1) && (sidx == 1 || sidx == 9 || sidx == 12)) {
            PH(3) { const int K = (sidx == 9) ? D : FF; const size_t wo = (sidx == 1) ? WS_WD1 : (sidx == 9 ? WS_WOUT : WS_WD2);
              pg8::Gemm g{BIG, (const bf16*)(wsw + wo), M, D, K, 1 << 30, 0, BIGP}; pg8::StaticOrder So; So.init(M, D, G, bx);
              pg8::EpiY16 E{XN, D}; pg8::gemm_phase<pg8::EpiY16, pg8::StaticOrder, true, true>(ldsL, g, So, E); }
        } else if ((ALL || KIND == 2) && (sidx == 2 || sidx == 10 || sidx == 13)) {
            PH(1) { const int tid = opaque_tid(), lane = tid & 63, wave = __builtin_amdgcn_readfirstlane(tid >> 6);
              const int gw = grp ? ((((bx & 7) * 16 + ((bx >> 3) & 7)) << 16) | ((bx >> 6) * 64 + wave * 8)) : (bx * NWAVES + wave), NGW = grp ? -1 : G * NWAVES;
              const float* hin = (step == 2) ? AIN(a, 0) : AOUT(a);
              const float* gpost = AIN(a, sidx == 2 ? 4 : (sidx == 10 ? 17 : 21)) + l * D; const float coef = (sidx == 10) ? 1.0f : 0.5f;
              const float* gnext = (sidx == 2) ? AIN(a, 5) + l * D : (sidx == 10 ? AIN(a, 18) + l * D : (l + 1 < DEPTH ? AIN(a, 1) + (l + 1) * D : nullptr));
              row_phase(hin, AOUT(a), (const float*)XN, gpost, coef, gnext, XN, gw, NGW, lane); }
        } else if ((ALL || KIND == 3) && sidx == 3) {
            PH(4) { const float* cosT = (const float*)(ws + WS_ROPE); pg8::Gemm g{XN, (const bf16*)(wsw + WS_WQKV), M, NQKV, D, 1 << 30, 0}; pg8::StaticOrder So; So.init(M, NQKV, G, bx);
              pg8::EpiQKV E{BIG, NQKV, cosT, cosT + 8192 * 32}; pg8::gemm_phase<pg8::EpiQKV, pg8::StaticOrder, true, true>(ldsL, g, So, E); }
        } else if ((ALL || KIND == 4) && sidx == 4) {
            PH(5) { const int vcu = (G % 8 == 0) ? (bx % 8) * (G / 8) + bx / 8 : bx; attention_phase<0>(a, l, (char*)lds, vcu, G); }
        } else if ((ALL || KIND == 5) && sidx == 5) {
            PH(8) { const int vcu = (G % 8 == 0) ? (bx % 8) * (G / 8) + bx / 8 : bx; attention_phase<1>(a, l, (char*)lds, vcu, G); }
        } else if ((ALL || KIND == 6) && sidx == 6) {
            PH(9) { const int vcu = (G % 8 == 0) ? (bx % 8) * (G / 8) + bx / 8 : bx; attention_phase<2>(a, l, (char*)lds, vcu, G); }
        } else if ((ALL || KIND == 7) && sidx == 7) {
            PH(6) { pg8::Gemm g{XN, (const bf16*)(wsw + WS_WGATE), M, NGATE, D, 1 << 30, 0}; pg8::StaticOrder So; So.init(M, NGATE, G, bx);
              pg8::EpiGate E{BIG, BIGP, AIN(a, 15) + (size_t)l * NGATE}; pg8::gemm_phase<pg8::EpiGate, pg8::StaticOrder, true, true>(ldsL, g, So, E); }
        } else if ((ALL || KIND == 8) && sidx == 8) {
            PH(7) { for (int br = 0; br < 3; ++br) {
                pg8::Gemm g{(const bf16*)(ws + WS_OATT) + (size_t)br * M * 512, (const bf16*)(wsw + WS_WBR) + (size_t)br * D * 512, M, D, 512, 1 << 30, 0, 0}; pg8::StaticOrder So; So.init(M, D, G, bx);
                pg8::EpiBranchAcc E{BIG, BIGP, br * D, br == 0}; pg8::gemm_phase<pg8::EpiBranchAcc, pg8::StaticOrder, true, true>(ldsL, g, So, E); } }
        }
        if (step + 1 < step_hi && sidx != 4 && sidx != 5) {
            if (grp && sidx != 3 && sidx != 6) group_sync((unsigned*)(AWS(ARGS()) + WS_CTL) + (((bx & 7) * 8 + ((bx >> 3) & 7)) * 64), gtarget, gsame);
            else gsync(grid);
        }
    }

#ifdef DBG_SANITIZE
    gsync(grid);
    { KArgP a = ARGS(); float* o = AOUT(a); for (size_t i = (size_t)bx0 * 512 + threadIdx.x; i < (size_t)M * D; i += (size_t)G0 * 512) { float v = o[i]; if (!(fabsf(v) < 1e30f)) o[i] = 777.f; } }
#endif
}

#ifndef MK_PER_PHASE
#define MK_PER_PHASE 0
#endif
#ifdef DBG_DUMP
#define DBG_DUMP_EXTRA 1
#else
#define DBG_DUMP_EXTRA 0
#endif
extern "C" void kernel_launch(void* const* d_in, const int* in_sizes, int n_in, void* d_out, int out_size, void* d_ws, size_t ws_size, hipStream_t stream) {
    static int grid = 0;
    if (grid == 0) {
        if (n_in != 22 || in_sizes[0] != M * D || out_size != M * D || ws_size < WS_END) { fprintf(stderr, "kernel_launch: unexpected shapes (n_in %d in0 %d out %d ws %zu, need ws >= %zu); nothing launched\n", n_in, n_in > 0 ? in_sizes[0] : -1, out_size, ws_size, (size_t)WS_END); grid = -1; return; }
        int dev = 0, cus = 0, per_cu = 0;
        if (hipGetDevice(&dev) != hipSuccess || hipDeviceGetAttribute(&cus, hipDeviceAttributeMultiprocessorCount, dev) != hipSuccess) { grid = -1; return; }
        bool okattr = true;
#define SETA(k) okattr = okattr && (hipFuncSetAttribute((const void*)fwd_megakernel<k>, hipFuncAttributeMaxDynamicSharedMemorySize, LDS_BYTES) == hipSuccess)
        SETA(-1);
#if MK_PER_PHASE
        SETA(0); SETA(1); SETA(2); SETA(3); SETA(4); SETA(5); SETA(6); SETA(7); SETA(8); SETA(9); SETA(10);
#endif
        if (!okattr) { fprintf(stderr, "kernel_launch: hipFuncSetAttribute failed\n"); grid = -1; return; }
        if (hipOccupancyMaxActiveBlocksPerMultiprocessor(&per_cu, (const void*)fwd_megakernel<-1>, NWAVES * 64, LDS_BYTES) != hipSuccess || per_cu < 1) per_cu = 1;
        (void)hipGetLastError();
        grid = cus;
    }
    if (grid < 0) return;
    Args a{};
    for (int i = 0; i < 22; ++i) a.in[i] = (unsigned long long)(uintptr_t)d_in[i];
    a.out = (unsigned long long)(uintptr_t)d_out; a.ws = (unsigned long long)(uintptr_t)d_ws;
#ifdef DBG_DUMP
#define DBG_DUMP_EXTRA 1
#else
#define DBG_DUMP_EXTRA 0
#endif
#ifndef MK_PER_PHASE
#define MK_PER_PHASE 0
#endif
#if MK_PER_PHASE
    {
        for (int s = -1; s < MAXSTEP + DBG_DUMP_EXTRA; ++s) { a.step_lo = s; a.step_hi = s + 1;
            const int sx = s < 0 ? -1 : s % 14;
            const int kind = (s < 0) ? 9 : (s == MAXSTEP && DBG_DUMP_EXTRA) ? 10 : (sx == 0 || sx == 11) ? 0 : (sx == 1 || sx == 9 || sx == 12) ? 1 : (sx == 2 || sx == 10 || sx == 13) ? 2 : sx;
#define LK(k) case k: hipLaunchKernelGGL(fwd_megakernel<k>, dim3(grid), dim3(NWAVES * 64), LDS_BYTES, stream, a); break;
            switch (kind) { LK(0) LK(1) LK(2) LK(3) LK(4) LK(5) LK(6) LK(7) LK(8) LK(9) LK(10) }
        }
    }
#else
    {
        a.step_lo = -1; a.step_hi = MAXSTEP + DBG_DUMP_EXTRA;
        void* args[] = {&a};
        hipError_t e = hipLaunchCooperativeKernel((const void*)fwd_megakernel<-1>, dim3(grid), dim3(NWAVES * 64), args, LDS_BYTES, stream);
        if (e != hipSuccess) fprintf(stderr, "kernel_launch: cooperative launch failed: %s (grid %d)\n", hipGetErrorString(e), grid);
    }
#endif
}
```

```cpp
#include <hip/hip_runtime.h>
#include <hip/hip_cooperative_groups.h>
#include <cstdio>
#include <cstdint>
namespace cg = cooperative_groups;

__device__ __forceinline__ int opaque_tid() { int t = threadIdx.x; asm volatile("" : "+v"(t)); return t; }
__device__ __forceinline__ int opaque_s(int x) { asm volatile("" : "+s"(x)); return x; }

#define GASQ __attribute__((address_space(1)))
template <class T> __device__ __forceinline__ T* as_global(T* p) { return (T*)(GASQ T*)p; }
__device__ __forceinline__ void gsync(cg::grid_group& g) {
    asm volatile("s_waitcnt vmcnt(0)" ::: "memory");
    g.sync();
    if (threadIdx.x < 64) {
        __builtin_amdgcn_fence(__ATOMIC_ACQUIRE, "agent");
        asm volatile("s_waitcnt vmcnt(0)" ::: "memory");
    }
    __syncthreads();
}

__device__ __forceinline__ void group_sync(unsigned* cnt, unsigned& target, unsigned& same_xcd) {
    asm volatile("s_waitcnt vmcnt(0)" ::: "memory");
    __syncthreads();
    target += 4u;
    if (threadIdx.x < 64) {
        if (!same_xcd) { __builtin_amdgcn_fence(__ATOMIC_RELEASE, "agent"); asm volatile("s_waitcnt vmcnt(0)" ::: "memory"); }
        if (threadIdx.x == 0) __hip_atomic_fetch_add(cnt, 1u, __ATOMIC_RELAXED, __HIP_MEMORY_SCOPE_AGENT);
        while (__hip_atomic_load(cnt, __ATOMIC_RELAXED, __HIP_MEMORY_SCOPE_AGENT) < target) __builtin_amdgcn_s_sleep(2);
        __builtin_amdgcn_fence(__ATOMIC_ACQUIRE, "agent");
        asm volatile("s_waitcnt vmcnt(0)" ::: "memory");
        const unsigned mask = __hip_atomic_load(cnt + 1, __ATOMIC_RELAXED, __HIP_MEMORY_SCOPE_AGENT);
        same_xcd = (__builtin_popcount(mask) == 1) ? 1u : 0u;
    }
    __syncthreads();
}

namespace pg8 {
#define PG8_LAS __attribute__((address_space(3)))
typedef unsigned short bf16_t;
typedef short bf16x8 __attribute__((ext_vector_type(8)));
typedef float f32x4 __attribute__((ext_vector_type(4)));
typedef unsigned u32x4 __attribute__((ext_vector_type(4)));
constexpr int BM = 256, BK = 64, HALF = 128, HTB = HALF * BK * 2  , STAGE_BYTES = 8 * HTB, NXCD = 8, WGM = 8;

__host__ __device__ __forceinline__ int lds_byte(int r, int c) { const int st = (r >> 4) * 2 + (c >> 5), rr = r & 15, cc = c & 31, ob = rr * 64 + cc * 2; return st * 1024 + (ob ^ (((ob >> 9) & 1) << 5)); }
__host__ __device__ __forceinline__ void stage_rc(int b, int& R, int& C) { const int st = b / 1024, sb = b % 1024, swz = sb ^ (((sb >> 9) & 1) << 5); R = (st >> 1) * 16 + swz / 64; C = (st & 1) * 32 + (swz % 64) / 2; }
__host__ __device__ __forceinline__ int perm32(int rho) { const int n = rho >> 4, i = rho & 15; return 8 * (i >> 2) + 4 * n + (i & 3); }

struct Unit { int pm, pn; };
struct Gemm { const bf16_t* A; const bf16_t* Bt; int M, N, K; int adiv; size_t astride; int lda; };

struct StaticOrder {
    int nM, nN, nwg, G, c;
    __host__ __device__ void init(int M, int N, int G_, int c_) { nM = M / BM; nN = N / BM; nwg = nM * nN; G = G_; c = c_; }
    __host__ __device__ bool next(int i, Unit& u) const {
        const long L = (long)i * G + c; if (L >= nwg) return false;
        int wgid = (int)L; { const int q = nwg / NXCD, r = nwg % NXCD, xcd = wgid % NXCD, off = wgid / NXCD; wgid = (xcd < r ? xcd * (q + 1) : r * (q + 1) + (xcd - r) * q) + off; }
        const int nig = WGM * nN, gid = wgid / nig, fm = gid * WGM, gsz = (nM - fm) < WGM ? (nM - fm) : WGM;
        u.pm = fm + ((wgid % nig) % gsz); u.pn = (wgid % nig) / gsz; return true;
    }
    __device__ __forceinline__ void a_ready(const Unit&) const {}
    __device__ __forceinline__ void done(const Unit&) const {}
};


__device__ __forceinline__ unsigned cvt_pk_bf16(float lo, float hi) { unsigned r; asm volatile("s_nop 1\n\tv_cvt_pk_bf16_f32 %0, %1, %2" : "=v"(r) : "v"(lo), "v"(hi)); return r; }
__device__ __forceinline__ float bf_lo(unsigned w) { return __uint_as_float(w << 16); }
__device__ __forceinline__ float bf_hi(unsigned w) { return __uint_as_float(w & 0xffff0000u); }
__device__ __forceinline__ float sigmoidf_fast(float x) { return __builtin_amdgcn_rcpf(1.0f + __builtin_amdgcn_exp2f(-1.4426950408889634f * x)); }

struct EpiSwiGLU {
    static constexpr bool PERM = true, AFTER_DRAIN = false;
    bf16_t* O; int ldc;
    __device__ __forceinline__ void operator()(const f32x4 (&acc)[2][2][4][2], const Unit& u, int wr, int wc, int fr, int fq) const {
        const int row0 = u.pm * BM + wr * 64 + fr, col0 = u.pn * HALF + wc * 32 + 8 * fq;
#pragma unroll
        for (int ai = 0; ai < 2; ++ai)
#pragma unroll
            for (int m = 0; m < 4; ++m) { bf16_t* rowp = O + (size_t)(row0 + ai * HALF + m * 16) * ldc + col0;
                float v[8];
#pragma unroll
                for (int n = 0; n < 2; ++n)
#pragma unroll
                    for (int e = 0; e < 4; ++e) { const float g = acc[ai][0][m][n][e], up = acc[ai][1][m][n][e]; v[n * 4 + e] = g * sigmoidf_fast(g) * up; }
                u32x4 w; w.x = cvt_pk_bf16(v[0], v[1]); w.y = cvt_pk_bf16(v[2], v[3]); w.z = cvt_pk_bf16(v[4], v[5]); w.w = cvt_pk_bf16(v[6], v[7]);
                *(u32x4*)rowp = w; }
    }
};
struct EpiF32 {
    static constexpr bool PERM = false, AFTER_DRAIN = false;
    float* Y; int ldc;
    __device__ __forceinline__ void operator()(const f32x4 (&acc)[2][2][4][2], const Unit& u, int wr, int wc, int fr, int fq) const {
        const int row0 = u.pm * BM + wr * 64 + fr, col0 = u.pn * BM + wc * 32 + 4 * fq;
#pragma unroll
        for (int ai = 0; ai < 2; ++ai)
#pragma unroll
            for (int m = 0; m < 4; ++m) { float* rowp = Y + (size_t)(row0 + ai * HALF + m * 16) * ldc + col0;
#pragma unroll
                for (int bj = 0; bj < 2; ++bj)
#pragma unroll
                    for (int n = 0; n < 2; ++n) *(f32x4*)(rowp + bj * HALF + n * 16) = acc[ai][bj][m][n]; }
    }
};
struct EpiY16 {
    static constexpr bool PERM = true, AFTER_DRAIN = false;
    bf16_t* Y; int ldc;
    __device__ __forceinline__ void operator()(const f32x4 (&acc)[2][2][4][2], const Unit& u, int wr, int wc, int fr, int fq) const {
        const int row0 = u.pm * BM + wr * 64 + fr, col0 = u.pn * BM + wc * 32 + 8 * fq;
#pragma unroll
        for (int ai = 0; ai < 2; ++ai)
#pragma unroll
            for (int m = 0; m < 4; ++m) { bf16_t* rowp = Y + (size_t)(row0 + ai * HALF + m * 16) * ldc + col0;
#pragma unroll
                for (int bj = 0; bj < 2; ++bj) { const f32x4 v0 = acc[ai][bj][m][0], v1 = acc[ai][bj][m][1];
                    u32x4 w; w.x = cvt_pk_bf16(v0[0], v0[1]); w.y = cvt_pk_bf16(v0[2], v0[3]); w.z = cvt_pk_bf16(v1[0], v1[1]); w.w = cvt_pk_bf16(v1[2], v1[3]);
                    *(u32x4*)(rowp + bj * HALF) = w; } }
    }
};
struct EpiQKV {
    static constexpr bool PERM = false, AFTER_DRAIN = false;
    bf16_t* O; int ldc; const float* cosT; const float* sinT;
    __device__ __forceinline__ static bool is_rope(int c128) { return (c128 >= 1536 && c128 < 2176) || (c128 >= 2304 && c128 < 3328); }
    __device__ __forceinline__ void operator()(const f32x4 (&acc)[2][2][4][2], const Unit& u, int wr, int wc, int fr, int fq) const {
        typedef unsigned u32x2v __attribute__((ext_vector_type(2)));
        const int row0 = u.pm * BM + wr * 64 + fr, w2 = wc & 1, dd = 16 * w2 + 4 * fq;
        const bool r0 = is_rope(u.pn * BM), r1 = is_rope(u.pn * BM + HALF);
#pragma unroll
        for (int ai = 0; ai < 2; ++ai)
#pragma unroll
            for (int m = 0; m < 4; ++m) { const int row = row0 + ai * HALF + m * 16; const int s = row & 8191;
                f32x4 cs = (f32x4){1.f, 1.f, 1.f, 1.f}, sn = (f32x4){0.f, 0.f, 0.f, 0.f};
                if (r0 || r1) { cs = *(const f32x4*)(cosT + s * 32 + dd); sn = *(const f32x4*)(sinT + s * 32 + dd); }
#pragma unroll
                for (int bj = 0; bj < 2; ++bj) { const bool rp = bj ? r1 : r0;
                    const f32x4 x1 = acc[ai][bj][m][0], x2 = acc[ai][bj][m][1];
                    f32x4 o1 = x1, o2 = x2;
                    if (rp) { o1 = x1 * cs - x2 * sn; o2 = x2 * cs + x1 * sn; }
                    bf16_t* p = O + (size_t)row * ldc + u.pn * BM + bj * HALF + (wc >> 1) * 64 + dd;
                    u32x2v a, b; a.x = cvt_pk_bf16(o1[0], o1[1]); a.y = cvt_pk_bf16(o1[2], o1[3]); b.x = cvt_pk_bf16(o2[0], o2[1]); b.y = cvt_pk_bf16(o2[2], o2[3]);
                    *(u32x2v*)p = a; *(u32x2v*)(p + 32) = b; } }
    }
};
struct EpiGate {
    static constexpr bool PERM = true, AFTER_DRAIN = false;
    bf16_t* O; int ldc; const float* bias;
    __device__ __forceinline__ void operator()(const f32x4 (&acc)[2][2][4][2], const Unit& u, int wr, int wc, int fr, int fq) const {
        const int row0 = u.pm * BM + wr * 64 + fr, col0 = u.pn * BM + wc * 32 + 8 * fq;
        f32x4 bv[2][2];
#pragma unroll
        for (int bj = 0; bj < 2; ++bj)
#pragma unroll
            for (int n = 0; n < 2; ++n) bv[bj][n] = *(const f32x4*)(bias + col0 + bj * HALF + 4 * n);
#pragma unroll
        for (int ai = 0; ai < 2; ++ai)
#pragma unroll
            for (int m = 0; m < 4; ++m) { bf16_t* rowp = O + (size_t)(row0 + ai * HALF + m * 16) * ldc + col0;
#pragma unroll
                for (int bj = 0; bj < 2; ++bj) { const f32x4 v0 = acc[ai][bj][m][0] + bv[bj][0], v1 = acc[ai][bj][m][1] + bv[bj][1];
                    u32x4 w; w.x = cvt_pk_bf16(sigmoidf_fast(v0[0]), sigmoidf_fast(v0[1])); w.y = cvt_pk_bf16(sigmoidf_fast(v0[2]), sigmoidf_fast(v0[3]));
                    w.z = cvt_pk_bf16(sigmoidf_fast(v1[0]), sigmoidf_fast(v1[1])); w.w = cvt_pk_bf16(sigmoidf_fast(v1[2]), sigmoidf_fast(v1[3]));
                    *(u32x4*)(rowp + bj * HALF) = w; } }
    }
};
struct EpiMulInPlace {
    static constexpr bool PERM = true, AFTER_DRAIN = false;
    bf16_t* O; int ldc;
    __device__ __forceinline__ void operator()(const f32x4 (&acc)[2][2][4][2], const Unit& u, int wr, int wc, int fr, int fq) const {
        const int row0 = u.pm * BM + wr * 64 + fr, col0 = u.pn * BM + wc * 32 + 8 * fq;
#pragma unroll
        for (int ai = 0; ai < 2; ++ai)
#pragma unroll
            for (int m = 0; m < 4; ++m) { bf16_t* rowp = O + (size_t)(row0 + ai * HALF + m * 16) * ldc + col0;
#pragma unroll
                for (int bj = 0; bj < 2; ++bj) { const u32x4 g = *(const u32x4*)(rowp + bj * HALF); const f32x4 v0 = acc[ai][bj][m][0], v1 = acc[ai][bj][m][1];
                    u32x4 w; w.x = cvt_pk_bf16(v0[0] * bf_lo(g.x), v0[1] * bf_hi(g.x)); w.y = cvt_pk_bf16(v0[2] * bf_lo(g.y), v0[3] * bf_hi(g.y));
                    w.z = cvt_pk_bf16(v1[0] * bf_lo(g.z), v1[1] * bf_hi(g.z)); w.w = cvt_pk_bf16(v1[2] * bf_lo(g.w), v1[3] * bf_hi(g.w));
                    *(u32x4*)(rowp + bj * HALF) = w; } }
    }
};
struct EpiBranchAcc {
    static constexpr bool PERM = true, AFTER_DRAIN = false;
    bf16_t* O; int ldc; int gcol0; int first;
    __device__ __forceinline__ void operator()(const f32x4 (&acc)[2][2][4][2], const Unit& u, int wr, int wc, int fr, int fq) const {
        const int row0 = u.pm * BM + wr * 64 + fr, col0 = u.pn * BM + wc * 32 + 8 * fq;
#pragma unroll
        for (int ai = 0; ai < 2; ++ai)
#pragma unroll
            for (int m = 0; m < 4; ++m) { bf16_t* rowp = O + (size_t)(row0 + ai * HALF + m * 16) * ldc + col0;
#pragma unroll
                for (int bj = 0; bj < 2; ++bj) { const u32x4 g = *(const u32x4*)(rowp + gcol0 + bj * HALF); const f32x4 v0 = acc[ai][bj][m][0], v1 = acc[ai][bj][m][1];
                    float r[8] = {v0[0] * bf_lo(g.x), v0[1] * bf_hi(g.x), v0[2] * bf_lo(g.y), v0[3] * bf_hi(g.y), v1[0] * bf_lo(g.z), v1[1] * bf_hi(g.z), v1[2] * bf_lo(g.w), v1[3] * bf_hi(g.w)};
                    if (!first) { const u32x4 p = *(const u32x4*)(rowp + bj * HALF);
                        r[0] += bf_lo(p.x); r[1] += bf_hi(p.x); r[2] += bf_lo(p.y); r[3] += bf_hi(p.y); r[4] += bf_lo(p.z); r[5] += bf_hi(p.z); r[6] += bf_lo(p.w); r[7] += bf_hi(p.w); }
                    u32x4 w; w.x = cvt_pk_bf16(r[0], r[1]); w.y = cvt_pk_bf16(r[2], r[3]); w.z = cvt_pk_bf16(r[4], r[5]); w.w = cvt_pk_bf16(r[6], r[7]);
                    *(u32x4*)(rowp + bj * HALF) = w; } }
    }
};

template <class Epi, class Sched, bool ALIGN_EPI = false, bool SP2 = false>
__device__ __forceinline__ void gemm_phase(PG8_LAS unsigned char* lds, const Gemm g, const Sched& S, const Epi& E) {
    const int tid = opaque_tid(), wid = __builtin_amdgcn_readfirstlane(tid >> 6), lane = tid & 63, wr = wid >> 2, wc = wid & 3, fr = lane & 15, fq = lane >> 4;
    const int K = g.K, nt = K / BK, lda = g.lda ? g.lda : g.K;
    unsigned voffA[2], voffB[2];
#pragma unroll
    for (int i = 0; i < 2; ++i) { int R, C; stage_rc(tid * 16 + i * 8192, R, C); const int Rb = Epi::PERM ? ((R & ~31) + perm32(R & 31)) : R;
        voffA[i] = (unsigned)(R * lda + C) * 2u; voffB[i] = (unsigned)(Rb * K + C) * 2u; }
    const size_t kstep = (size_t)(BK * 2);
    const size_t hstepA = (size_t)HALF * lda * 2, tstepA = 2 * hstepA;
    const size_t hstep = (size_t)HALF * K * 2;
    const size_t tstep = 2 * hstep;
    const unsigned ldsw = (unsigned)wid * 1024u;
    const int aoff = lds_byte(wr * 64 + fr, fq * 8), boff = lds_byte(wc * 32 + fr, fq * 8);
#define PG8_SA(b, h) (((b) * 2 + (h)) * HTB)
#define PG8_SB(b, h) ((4 + (b) * 2 + (h)) * HTB)
#define PG8_STAGE(bufoff, gbase, voff) do { _Pragma("unroll") for (int _i = 0; _i < 2; ++_i) \
        __builtin_amdgcn_global_load_lds((const unsigned*)((const char*)(gbase) + (voff)[_i]), (PG8_LAS unsigned*)(lds + (bufoff) + ldsw + _i * 8192), 16, 0, 0); } while (0)
#define PG8_LDA(dst, b, h) do { _Pragma("unroll") for (int m = 0; m < 4; ++m) _Pragma("unroll") for (int k = 0; k < 2; ++k) dst[m][k] = *(const PG8_LAS bf16x8*)(lds + PG8_SA(b, h) + aoff + m * 2048 + k * 1024); } while (0)
#define PG8_LDB(dst, b, h) do { _Pragma("unroll") for (int n = 0; n < 2; ++n) _Pragma("unroll") for (int k = 0; k < 2; ++k) dst[n][k] = *(const PG8_LAS bf16x8*)(lds + PG8_SB(b, h) + boff + n * 2048 + k * 1024); } while (0)
#define PG8_MMA(ai, bj, At, Bt) do { __builtin_amdgcn_s_setprio(1); _Pragma("unroll") for (int m = 0; m < 4; ++m) _Pragma("unroll") for (int n = 0; n < 2; ++n) _Pragma("unroll") for (int k = 0; k < 2; ++k) \
        acc[ai][bj][m][n] = __builtin_amdgcn_mfma_f32_16x16x32_bf16(Bt[n][k], At[m][k], acc[ai][bj][m][n], 0, 0, 0); __builtin_amdgcn_s_setprio(0); } while (0)
#define PG8_WAIT_V(n) asm volatile("s_waitcnt vmcnt(" #n ")" ::: "memory")
#define PG8_WAIT_L(n) asm volatile("s_waitcnt lgkmcnt(" #n ")" ::: "memory")
#define PG8_BAR __builtin_amdgcn_s_barrier()
#define PG8_SCHED __builtin_amdgcn_sched_barrier(0)
    Unit cur, nxt; int ui = 0;
    if (!S.next(0, cur)) return;
    f32x4 acc[2][2][4][2];
#pragma unroll
    for (int a = 0; a < 2; ++a)
#pragma unroll
        for (int b = 0; b < 2; ++b)
#pragma unroll
            for (int m = 0; m < 4; ++m)
#pragma unroll
                for (int n = 0; n < 2; ++n) acc[a][b][m][n] = (f32x4){0.f, 0.f, 0.f, 0.f};
    bf16x8 At[4][2], B0[2][2], B1[2][2];
    const char* cA = (const char*)g.A + (size_t)cur.pm * tstepA + (size_t)(cur.pn / g.adiv) * g.astride; const char* cB = (const char*)g.Bt + (size_t)cur.pn * tstep;
    S.a_ready(cur);
    if constexpr (SP2) {
        PG8_STAGE(PG8_SB(0, 0), cB, voffB); PG8_STAGE(PG8_SB(0, 1), cB + hstep, voffB); PG8_STAGE(PG8_SA(0, 0), cA, voffA); PG8_STAGE(PG8_SA(0, 1), cA + hstepA, voffA);
        if (wr == 1) PG8_BAR;
        PG8_WAIT_V(2); PG8_BAR;
        PG8_STAGE(PG8_SB(1, 0), cB + kstep, voffB); PG8_STAGE(PG8_SA(1, 0), cA + kstep, voffA); PG8_STAGE(PG8_SB(1, 1), cB + hstep + kstep, voffB);
        PG8_WAIT_V(6); PG8_BAR;
    } else {
        PG8_STAGE(PG8_SB(0, 0), cB, voffB); PG8_STAGE(PG8_SA(0, 0), cA, voffA); PG8_STAGE(PG8_SB(0, 1), cB + hstep, voffB); PG8_STAGE(PG8_SA(0, 1), cA + hstepA, voffA);
        if (wr == 1) PG8_BAR;
        PG8_WAIT_V(4); PG8_BAR;
        PG8_STAGE(PG8_SB(1, 0), cB + kstep, voffB); PG8_STAGE(PG8_SA(1, 0), cA + kstep, voffA); PG8_STAGE(PG8_SB(1, 1), cB + hstep + kstep, voffB);
        PG8_WAIT_V(6); PG8_BAR;
    }
    for (;;) {
        const bool has_next = S.next(ui + 1, nxt);
        const char* nA = has_next ? (const char*)g.A + (size_t)nxt.pm * tstepA + (size_t)(nxt.pn / g.adiv) * g.astride : cA; const char* nB = has_next ? (const char*)g.Bt + (size_t)nxt.pn * tstep : cB;
        for (int t = 0; t < nt; t += 2) {
            const bool last = (t == nt - 2);
            const char* a1 = cA + (size_t)(t + 1) * kstep;
            const char* a2 = last ? nA : cA + (size_t)(t + 2) * kstep; const char* b2 = last ? nB : cB + (size_t)(t + 2) * kstep;
            const char* a3 = a2 + kstep; const char* b3 = b2 + kstep;
            if (last && has_next) S.a_ready(nxt);
            if constexpr (SP2) {
            PG8_LDB(B0, 0, 0); PG8_LDB(B1, 0, 1); PG8_SCHED; PG8_LDA(At, 0, 0); PG8_STAGE(PG8_SA(1, 1), a1 + hstepA, voffA);
            PG8_WAIT_V(8); PG8_WAIT_L(0); PG8_BAR; PG8_MMA(0, 0, At, B0); PG8_MMA(0, 1, At, B1); PG8_BAR; PG8_SCHED;
            PG8_LDA(At, 0, 1); PG8_STAGE(PG8_SB(0, 0), b2, voffB); PG8_STAGE(PG8_SB(0, 1), b2 + hstep, voffB); PG8_STAGE(PG8_SA(0, 0), a2, voffA);
            PG8_WAIT_V(8); PG8_WAIT_L(0); PG8_BAR; PG8_MMA(1, 0, At, B0); PG8_MMA(1, 1, At, B1); PG8_BAR; PG8_SCHED;
            PG8_LDB(B0, 1, 0); PG8_LDB(B1, 1, 1); PG8_SCHED; PG8_LDA(At, 1, 0); PG8_STAGE(PG8_SA(0, 1), a2 + hstepA, voffA);
            PG8_WAIT_V(8); PG8_WAIT_L(0); PG8_BAR; PG8_MMA(0, 0, At, B0); PG8_MMA(0, 1, At, B1); PG8_BAR; PG8_SCHED;
            PG8_LDA(At, 1, 1); PG8_STAGE(PG8_SB(1, 0), b3, voffB); PG8_STAGE(PG8_SB(1, 1), b3 + hstep, voffB); PG8_STAGE(PG8_SA(1, 0), a3, voffA);
            PG8_WAIT_V(8); PG8_WAIT_L(0); PG8_BAR; PG8_MMA(1, 0, At, B0); PG8_MMA(1, 1, At, B1); PG8_BAR; PG8_SCHED;
            } else {
            PG8_LDB(B0, 0, 0); PG8_SCHED; PG8_LDA(At, 0, 0); PG8_STAGE(PG8_SA(1, 1), a1 + hstepA, voffA);
            PG8_WAIT_L(8); PG8_BAR; PG8_WAIT_L(0); PG8_MMA(0, 0, At, B0); PG8_BAR; PG8_SCHED;
            PG8_LDB(B1, 0, 1); PG8_STAGE(PG8_SB(0, 0), b2, voffB);
            PG8_BAR; PG8_WAIT_L(0); PG8_MMA(0, 1, At, B1); PG8_BAR;
            PG8_LDA(At, 0, 1); PG8_STAGE(PG8_SA(0, 0), a2, voffA);
            PG8_BAR; PG8_WAIT_L(0); PG8_MMA(1, 0, At, B0); PG8_BAR; PG8_SCHED;
            PG8_STAGE(PG8_SB(0, 1), b2 + hstep, voffB);
            PG8_WAIT_V(6); PG8_BAR; PG8_MMA(1, 1, At, B1); PG8_BAR;
            PG8_LDB(B0, 1, 0); PG8_SCHED; PG8_LDA(At, 1, 0); PG8_STAGE(PG8_SA(0, 1), a2 + hstepA, voffA);
            PG8_WAIT_L(8); PG8_BAR; PG8_WAIT_L(0); PG8_MMA(0, 0, At, B0); PG8_BAR; PG8_SCHED;
            PG8_LDB(B1, 1, 1); PG8_STAGE(PG8_SB(1, 0), b3, voffB);
            PG8_BAR; PG8_WAIT_L(0); PG8_MMA(0, 1, At, B1); PG8_BAR;
            PG8_LDA(At, 1, 1); PG8_STAGE(PG8_SA(1, 0), a3, voffA);
            PG8_BAR; PG8_WAIT_L(0); PG8_MMA(1, 0, At, B0); PG8_BAR; PG8_SCHED;
            PG8_STAGE(PG8_SB(1, 1), b3 + hstep, voffB);
            PG8_WAIT_V(6); PG8_BAR; PG8_MMA(1, 1, At, B1); PG8_BAR;
            }
        }
        if constexpr (ALIGN_EPI) { if (wr == 0) PG8_BAR; }
        if constexpr (!Epi::AFTER_DRAIN) { E(acc, cur, wr, wc, fr, fq); S.done(cur); }
        if (!has_next) break;
#pragma unroll
        for (int a = 0; a < 2; ++a)
#pragma unroll
            for (int b = 0; b < 2; ++b)
#pragma unroll
                for (int m = 0; m < 4; ++m)
#pragma unroll
                    for (int n = 0; n < 2; ++n) acc[a][b][m][n] = (f32x4){0.f, 0.f, 0.f, 0.f};
        cur = nxt; cA = nA; cB = nB; ++ui;
        if constexpr (ALIGN_EPI) { if (wr == 1) PG8_BAR; }
    }
    PG8_WAIT_V(0);
    if constexpr (!ALIGN_EPI) { if (wr == 0) PG8_BAR; }
    PG8_BAR;
    if constexpr (Epi::AFTER_DRAIN) { E.fused(acc, cur, wr, wc, fr, fq, lds, wid, lane); S.done(cur); }
#undef PG8_SA
#undef PG8_SB
#undef PG8_STAGE
#undef PG8_LDA
#undef PG8_LDB
#undef PG8_MMA
#undef PG8_WAIT_V
#undef PG8_WAIT_L
#undef PG8_BAR
#undef PG8_SCHED
}

template <class Epi, class Sched>
__device__ __forceinline__ void gemm_plain(PG8_LAS unsigned char* lds, const Gemm g, const Sched& S, const Epi& E) {
    const int tid = opaque_tid(), wid = __builtin_amdgcn_readfirstlane(tid >> 6), lane = tid & 63, wr = wid >> 2, wc = wid & 3, fr = lane & 15, fq = lane >> 4;
    const int K = g.K, nk = K / 32;
    constexpr int PITCH = 80, TILE = 256 * PITCH;
    const int sr = tid >> 1, sh = tid & 1;
    const int srb = Epi::PERM ? ((sr & ~31) + perm32(sr & 31)) : sr;
    const size_t ga = (size_t)sr * K + sh * 16, gb = (size_t)srb * K + sh * 16;
    const int st = sr * PITCH + sh * 32;
    const int ard = (wr * 64 + fr) * PITCH + fq * 16, brd = (wc * 32 + fr) * PITCH + fq * 16;
    Unit cur;
    for (int ui = 0; S.next(ui, cur); ++ui) {
        const bf16_t* pA = g.A + (size_t)cur.pm * 256 * K + (size_t)(cur.pn / g.adiv) * (g.astride / 2) + ga;
        const bf16_t* pB = g.Bt + (size_t)cur.pn * 256 * K + gb;
        f32x4 acc[2][2][4][2];
#pragma unroll
        for (int a = 0; a < 2; ++a)
#pragma unroll
            for (int b = 0; b < 2; ++b)
#pragma unroll
                for (int m = 0; m < 4; ++m)
#pragma unroll
                    for (int n = 0; n < 2; ++n) acc[a][b][m][n] = (f32x4){0.f, 0.f, 0.f, 0.f};
        u32x4 ra0 = *(const u32x4*)(pA), ra1 = *(const u32x4*)(pA + 8), rb0 = *(const u32x4*)(pB), rb1 = *(const u32x4*)(pB + 8);
        *(PG8_LAS u32x4*)(lds + st) = ra0; *(PG8_LAS u32x4*)(lds + st + 16) = ra1;
        *(PG8_LAS u32x4*)(lds + TILE + st) = rb0; *(PG8_LAS u32x4*)(lds + TILE + st + 16) = rb1;
        __syncthreads();
        for (int kt = 0; kt < nk; ++kt) {
            const int cb = (kt & 1) * 2 * TILE, nb = ((kt + 1) & 1) * 2 * TILE;
            if (kt + 1 < nk) { ra0 = *(const u32x4*)(pA + (kt + 1) * 32); ra1 = *(const u32x4*)(pA + (kt + 1) * 32 + 8); rb0 = *(const u32x4*)(pB + (kt + 1) * 32); rb1 = *(const u32x4*)(pB + (kt + 1) * 32 + 8); }
            bf16x8 Bf[2][2];
#pragma unroll
            for (int bj = 0; bj < 2; ++bj)
#pragma unroll
                for (int n = 0; n < 2; ++n) Bf[bj][n] = *(const PG8_LAS bf16x8*)(lds + cb + TILE + brd + (bj * 128 + n * 16) * PITCH);
#pragma unroll
            for (int ai = 0; ai < 2; ++ai) {
                bf16x8 Af[4];
#pragma unroll
                for (int m = 0; m < 4; ++m) Af[m] = *(const PG8_LAS bf16x8*)(lds + cb + ard + (ai * 128 + m * 16) * PITCH);
#pragma unroll
                for (int bj = 0; bj < 2; ++bj)
#pragma unroll
                    for (int m = 0; m < 4; ++m)
#pragma unroll
                        for (int n = 0; n < 2; ++n) acc[ai][bj][m][n] = __builtin_amdgcn_mfma_f32_16x16x32_bf16(Bf[bj][n], Af[m], acc[ai][bj][m][n], 0, 0, 0);
            }
            if (kt + 1 < nk) { *(PG8_LAS u32x4*)(lds + nb + st) = ra0; *(PG8_LAS u32x4*)(lds + nb + st + 16) = ra1;
                               *(PG8_LAS u32x4*)(lds + nb + TILE + st) = rb0; *(PG8_LAS u32x4*)(lds + nb + TILE + st + 16) = rb1; }
            __syncthreads();
        }
        E(acc, cur, wr, wc, fr, fq);
    }
}
}

namespace att {
using bf16 = unsigned short;
using bf16x8 = __attribute__((ext_vector_type(8))) short;
using s16x4  = __attribute__((ext_vector_type(4))) short;
using f32x16 = __attribute__((ext_vector_type(16))) float;
using u32x4  = __attribute__((ext_vector_type(4))) unsigned;
constexpr int LDQKV = 3840;
constexpr float SCALE = 0.125f;
constexpr float THR = 8.f;
constexpr float NEGBIG = -1e30f;
constexpr float MINIT = -1e9f;
constexpr int OFF_V = 0, OFF_K = 49152, OFF_WS = 98304, OFF_RPB = 98304 + 2048, ATT_LDS = 98304 + 4096;
#define SBAR() __builtin_amdgcn_sched_barrier(0)
__device__ __forceinline__ int crow(int r, int hi) { return (r & 3) + 8 * (r >> 2) + 4 * hi; }
__device__ __forceinline__ constexpr int crow0(int r) { return (r & 3) + 8 * (r >> 2); }
__device__ __forceinline__ unsigned cvtpk(float lo, float hi) { unsigned r; asm volatile("s_nop 0\n\tv_cvt_pk_bf16_f32 %0, %1, %2" : "=v"(r) : "v"(lo), "v"(hi)); return r; }
template <int KW> __device__ __forceinline__ int kswz(int row, int colB) {
  if constexpr (KW == 128) return row * 256 + (colB ^ ((row & 7) << 4));
  else return row * 128 + (colB ^ (((row >> 1) & 7) << 4));
}
struct ModA { int qrow, qc, cs, rs, t0; const float* rpb; __device__ __forceinline__ bool need(int j) const { const int kr = t0 + j; return kr >= rs && kr < rs + 8; } };
struct ModB { int d0, lo, hi; __device__ __forceinline__ bool need(int j) const { return (64 * j + 63 >= lo) && (64 * j <= hi); } };
struct ModC { int dummy; __device__ __forceinline__ constexpr bool need(int) const { return true; } };

template <int MODE, class Mod> __device__ __forceinline__ void modify(f32x16& p0, f32x16& p1, const Mod& md, int j, int hi) {
  if constexpr (MODE == 0) {
    const int kr = md.t0 + j; const bool row_ok = (kr >= md.rs) && (kr < md.rs + 8);
    if (!row_ok) {
#pragma unroll
      for (int r = 0; r < 16; ++r) { p0[r] = NEGBIG; p1[r] = NEGBIG; }
    } else {
      const float* tb = md.rpb + (kr - md.qrow + 7) * 31;
      const int kc0 = 4 * hi - md.cs, dc0 = 4 * hi - md.qc + 15;
#pragma unroll
      for (int r = 0; r < 16; ++r) {
        { const int kc = kc0 + crow0(r); int dc = dc0 + crow0(r); dc = dc < 0 ? 0 : (dc > 30 ? 30 : dc); const float b = tb[dc]; p0[r] = ((unsigned)kc < 16u) ? p0[r] + b : NEGBIG; }
        { const int kc = kc0 + crow0(r) + 32; int dc = dc0 + crow0(r) + 32; dc = dc < 0 ? 0 : (dc > 30 ? 30 : dc); const float b = tb[dc]; p1[r] = ((unsigned)kc < 16u) ? p1[r] + b : NEGBIG; }
      }
    }
  } else if constexpr (MODE == 1) {
    const int base = md.d0 + j * 64 + 128;
#pragma unroll
    for (int r = 0; r < 16; ++r) {
      p0[r] = ((unsigned)(base + crow0(r)) <= 256u) ? p0[r] : NEGBIG;
      p1[r] = ((unsigned)(base + crow0(r) + 32) <= 256u) ? p1[r] : NEGBIG;
    }
  }
}
template <int MODE, class Mod> __device__ __forceinline__ void partialSM(f32x16& p0, f32x16& p1, float& m_reg, float& mn, float& alpha, const Mod& md, int j, int hi) {
  constexpr float C = SCALE * 1.4426950408889634f;
  modify<MODE, Mod>(p0, p1, md, j, hi);
  float pmax = p0[0];
#pragma unroll
  for (int r = 1; r < 16; ++r) pmax = fmaxf(pmax, p0[r]);
#pragma unroll
  for (int r = 0; r < 16; ++r) pmax = fmaxf(pmax, p1[r]);
  { auto rr = __builtin_amdgcn_permlane32_swap(__float_as_uint(pmax), __float_as_uint(pmax), false, false);
    pmax = fmaxf(__uint_as_float(rr[0]), __uint_as_float(rr[1])); }
  if (__builtin_expect(__all(pmax - m_reg <= THR / SCALE), 1)) { mn = m_reg; alpha = 1.f; }
  else { mn = fmaxf(m_reg, pmax); alpha = __builtin_amdgcn_exp2f((m_reg - mn) * C); m_reg = mn; }
  const float mnC = -mn * C;
#pragma unroll
  for (int r = 0; r < 16; ++r) p0[r] = fmaf(p0[r], C, mnC);
#pragma unroll
  for (int r = 0; r < 16; ++r) p1[r] = fmaf(p1[r], C, mnC);
#pragma unroll
  for (int r = 0; r < 16; ++r) p0[r] = __builtin_amdgcn_exp2f(p0[r]);
}
__device__ __forceinline__ void finishSM(f32x16& p0, f32x16& p1, float alpha, float& l_reg, bf16x8& pa0, bf16x8& pa1, bf16x8& pa2, bf16x8& pa3) {
#pragma unroll
  for (int r = 0; r < 16; ++r) p1[r] = __builtin_amdgcn_exp2f(p1[r]);
  float ps = 0;
#pragma unroll
  for (int r = 0; r < 16; ++r) ps += p0[r];
#pragma unroll
  for (int r = 0; r < 16; ++r) ps += p1[r];
  { auto rr = __builtin_amdgcn_permlane32_swap(__float_as_uint(ps), __float_as_uint(ps), false, false);
    ps = __uint_as_float(rr[0]) + __uint_as_float(rr[1]); }
  l_reg = l_reg * alpha + ps;
#define PK4(P, BASE, OUT) do { unsigned a0 = cvtpk(P[BASE + 0], P[BASE + 1]), a1 = cvtpk(P[BASE + 2], P[BASE + 3]);   \
    unsigned b0 = cvtpk(P[BASE + 4], P[BASE + 5]), b1 = cvtpk(P[BASE + 6], P[BASE + 7]);                              \
    auto r0 = __builtin_amdgcn_permlane32_swap(a0, b0, false, false); auto r1 = __builtin_amdgcn_permlane32_swap(a1, b1, false, false); \
    u32x4 w = {r0[0], r1[0], r0[1], r1[1]}; OUT = *reinterpret_cast<bf16x8*>(&w); } while (0)
  PK4(p0, 0, pa0); PK4(p0, 8, pa1); PK4(p1, 0, pa2); PK4(p1, 8, pa3);
#undef PK4
}
template <int KW> __device__ __forceinline__ void qkt(f32x16& p0, f32x16& p1, const char* Ks, const bf16x8 (&qr)[4], int r32, int hi, int kcolB) {
  p0 = f32x16{}; p1 = f32x16{};
#pragma unroll
  for (int d0 = 0; d0 < 4; ++d0) { const int cb = kcolB + (d0 * 16 + hi * 8) * 2;
    const bf16x8 b0 = *reinterpret_cast<const bf16x8*>(Ks + kswz<KW>(r32, cb));
    const bf16x8 b1 = *reinterpret_cast<const bf16x8*>(Ks + kswz<KW>(32 + r32, cb));
    p0 = __builtin_amdgcn_mfma_f32_32x32x16_bf16(b0, qr[d0], p0, 0, 0, 0);
    p1 = __builtin_amdgcn_mfma_f32_32x32x16_bf16(b1, qr[d0], p1, 0, 0, 0); }
}
template <int DV> __device__ __forceinline__ int v_st(int k, int c) { const int kk = (k & ~0xC) | ((k & 4) << 1) | ((k & 8) >> 1); return ((kk >> 3) * (DV / 32) + (c >> 5)) * 512 + ((kk & 7) * 32 + (c & 31)) * 2; }
__device__ __forceinline__ int v_rd_base(int lane) { return ((lane & 3) << 3) | (((lane >> 2) & 3) << 6) | (((lane >> 4) & 1) << 5) | (((lane >> 5) & 1) << 8); }
template <int DV> constexpr int v_rd_off(int d0, int ks, int half) { return d0 * 512 + ks * (DV / 32) * 1024 + half * (DV / 32) * 512; }
typedef __attribute__((address_space(3))) s16x4 lds_s16x4;
template <int OFF> __device__ __forceinline__ s16x4 tr_read(int vb) {
  return __builtin_amdgcn_ds_read_tr16_b64_v4i16((lds_s16x4*)(uintptr_t)(unsigned)((vb & 0x3ffff) + OFF));
}
template <int DV, int D0> __device__ __forceinline__ void pv_one(f32x16& od, int vb, bf16x8 pa0, bf16x8 pa1, bf16x8 pa2, bf16x8 pa3) {
  const s16x4 l0 = tr_read<v_rd_off<DV>(D0, 0, 0)>(vb), h0 = tr_read<v_rd_off<DV>(D0, 0, 1)>(vb), l1 = tr_read<v_rd_off<DV>(D0, 1, 0)>(vb), h1 = tr_read<v_rd_off<DV>(D0, 1, 1)>(vb);
  const s16x4 l2 = tr_read<v_rd_off<DV>(D0, 2, 0)>(vb), h2 = tr_read<v_rd_off<DV>(D0, 2, 1)>(vb), l3 = tr_read<v_rd_off<DV>(D0, 3, 0)>(vb), h3 = tr_read<v_rd_off<DV>(D0, 3, 1)>(vb);
#define PK(L, H) (bf16x8){L[0], L[1], L[2], L[3], H[0], H[1], H[2], H[3]}
  od = __builtin_amdgcn_mfma_f32_32x32x16_bf16(pa0, PK(l0, h0), od, 0, 0, 0);
  od = __builtin_amdgcn_mfma_f32_32x32x16_bf16(pa1, PK(l1, h1), od, 0, 0, 0);
  od = __builtin_amdgcn_mfma_f32_32x32x16_bf16(pa2, PK(l2, h2), od, 0, 0, 0);
  od = __builtin_amdgcn_mfma_f32_32x32x16_bf16(pa3, PK(l3, h3), od, 0, 0, 0);
#undef PK
}
template <int DV> __device__ __forceinline__ void pv_all(f32x16 (&o)[DV / 32], int vb, bf16x8 pa0, bf16x8 pa1, bf16x8 pa2, bf16x8 pa3) {
  pv_one<DV, 0>(o[0], vb, pa0, pa1, pa2, pa3); pv_one<DV, 1>(o[1], vb, pa0, pa1, pa2, pa3);
  if constexpr (DV == 128) { pv_one<DV, 2>(o[2], vb, pa0, pa1, pa2, pa3); pv_one<DV, 3>(o[3], vb, pa0, pa1, pa2, pa3); }
}

template <int KW, int DV, int MODE, class Mod>
__device__ __forceinline__ void attn_loop(const bf16* __restrict__ Qw, const bf16* __restrict__ Kt, const bf16* __restrict__ Vt, int NT, int kcolB, char* lds, const Mod& md,
                                          f32x16 (&o)[DV / 32], float& m_reg, float& l_reg) {
  constexpr int SHM_V = 64 * DV * 2, SHM_K = 64 * KW * 2, NKL = KW / 64, NVL = DV / 64;
  const int tid = opaque_tid(), wid = tid >> 6, lane = tid & 63, r32 = lane & 31, hi = lane >> 5;
  char* V_lds = lds + OFF_V; char* K_lds = lds + OFF_K;
  float* al_l = (float*)(lds + OFF_WS) + wid * 64 + 32;
  m_reg = MINIT; l_reg = 0.f;
#pragma unroll
  for (int d = 0; d < DV / 32; ++d) o[d] = f32x16{};
  bf16x8 qr[4];
#pragma unroll
  for (int d0 = 0; d0 < 4; ++d0) qr[d0] = *reinterpret_cast<const bf16x8*>(Qw + d0 * 16);
  const int ksr = (KW == 128) ? (tid >> 4) : (tid >> 3), ksc = (KW == 128) ? (tid & 15) * 8 : (tid & 7) * 8;
  const int vsr = (DV == 128) ? (tid >> 4) : (tid >> 3), vsc = (DV == 128) ? (tid & 15) * 8 : (tid & 7) * 8;
  const int vst0 = v_st<DV>(vsr, vsc), vst1 = v_st<DV>(32 + vsr, vsc);
  const int kst0 = kswz<KW>(ksr, ksc * 2), kst1 = kswz<KW>(32 + ksr, ksc * 2);
  const int vb0 = (int)(uintptr_t)V_lds + v_rd_base(lane);
  const bf16* Kp = Kt + (long)ksr * LDQKV + ksc; const bf16* Vp = Vt + (long)vsr * LDQKV + vsc;
  bf16x8 sK[NKL], sV[NVL];
#define SLOAD(k0) do { _Pragma("unroll") for (int q_ = 0; q_ < NVL; ++q_) sV[q_] = *reinterpret_cast<const bf16x8*>(Vp + (long)((k0) + 32 * q_) * LDQKV); \
    _Pragma("unroll") for (int q_ = 0; q_ < NKL; ++q_) sK[q_] = *reinterpret_cast<const bf16x8*>(Kp + (long)((k0) + 32 * q_) * LDQKV); } while (0)
#define SWRITE(b) do { *(bf16x8*)(V_lds + (b) * SHM_V + vst0) = sV[0]; if constexpr (NVL == 2) *(bf16x8*)(V_lds + (b) * SHM_V + vst1) = sV[NVL - 1]; \
    *(bf16x8*)(K_lds + (b) * SHM_K + kst0) = sK[0]; if constexpr (NKL == 2) *(bf16x8*)(K_lds + (b) * SHM_K + kst1) = sK[NKL - 1]; } while (0)
#define RESC(a) do { if (__any((a) < 1.f)) { if (hi == 0) al_l[r32] = (a); asm volatile("s_waitcnt lgkmcnt(0)" ::: "memory"); \
    _Pragma("unroll") for (int d = 0; d < DV / 32; ++d) _Pragma("unroll") for (int r = 0; r < 16; ++r) o[d][r] *= al_l[crow(r, hi)]; } } while (0)
  f32x16 pA0, pA1, pB0, pB1; float mnA, mnB, alA, alB; bf16x8 pa0, pa1, pa2, pa3;
  SLOAD(0); SWRITE(0); SLOAD(64);
  __syncthreads();
  if (md.need(0)) { qkt<KW>(pA0, pA1, K_lds, qr, r32, hi, kcolB); partialSM<MODE, Mod>(pA0, pA1, m_reg, mnA, alA, md, 0, hi); } else alA = 1.f;
  int b0 = 0, b1 = 1;
  for (int j = 1; j + 1 < NT; j += 2) {
    const bool n0 = md.need(j - 1), n1 = md.need(j), n2 = md.need(j + 1);
    const int b2 = (b1 == 2) ? 0 : b1 + 1;
    SWRITE(b1); SBAR(); SLOAD((j + 1) * 64); SBAR();
    __syncthreads();
    if (n1) qkt<KW>(pB0, pB1, K_lds + b1 * SHM_K, qr, r32, hi, kcolB);
    if (n0) finishSM(pA0, pA1, alA, l_reg, pa0, pa1, pa2, pa3); SBAR();
    if (n0) pv_all<DV>(o, vb0 + b0 * SHM_V, pa0, pa1, pa2, pa3); if (n1) partialSM<MODE, Mod>(pB0, pB1, m_reg, mnB, alB, md, j, hi); else alB = 1.f;
    RESC(alB);
    SBAR(); SWRITE(b2); SBAR(); if (j + 2 < NT) SLOAD((j + 2) * 64); SBAR();
    __syncthreads();
    if (n2) qkt<KW>(pA0, pA1, K_lds + b2 * SHM_K, qr, r32, hi, kcolB);
    if (n1) finishSM(pB0, pB1, alB, l_reg, pa0, pa1, pa2, pa3); SBAR();
    if (n1) pv_all<DV>(o, vb0 + b1 * SHM_V, pa0, pa1, pa2, pa3); if (n2) partialSM<MODE, Mod>(pA0, pA1, m_reg, mnA, alA, md, j + 1, hi); else alA = 1.f;
    RESC(alA);
    b0 = b2; b1 = (b2 == 2) ? 0 : b2 + 1;
  }
  { const bool t0_ = md.need(NT - 2), t1_ = md.need(NT - 1);
    SBAR(); SWRITE(b1); SBAR();
    __syncthreads();
    if (t1_) qkt<KW>(pB0, pB1, K_lds + b1 * SHM_K, qr, r32, hi, kcolB);
    if (t0_) finishSM(pA0, pA1, alA, l_reg, pa0, pa1, pa2, pa3); SBAR();
    if (t0_) pv_all<DV>(o, vb0 + b0 * SHM_V, pa0, pa1, pa2, pa3); if (t1_) partialSM<MODE, Mod>(pB0, pB1, m_reg, mnB, alB, md, NT - 1, hi); else alB = 1.f;
    RESC(alB);
    if (t1_) { finishSM(pB0, pB1, alB, l_reg, pa0, pa1, pa2, pa3); SBAR();
      pv_all<DV>(o, vb0 + b1 * SHM_V, pa0, pa1, pa2, pa3); } }
#undef SLOAD
#undef SWRITE
#undef RESC
}
}

typedef unsigned short bf16;
typedef float f32x4 __attribute__((ext_vector_type(4)));
typedef unsigned v4u __attribute__((ext_vector_type(4)));
typedef unsigned v2u __attribute__((ext_vector_type(2)));
constexpr int NWAVES = 8;
constexpr int NB = 4, S = 8192, D = 1024, FF = 2816, M = NB * S, DEPTH = 2;
constexpr int NQKV = 3840, NGATE = 3072, INCOLS = 6912;
constexpr float EPS = 1e-6f;
constexpr size_t MiB = 1u << 20;
constexpr size_t WS_WGU1 = 0, WS_WD1 = 11 * MiB, WS_WQKV = 16 * MiB + MiB / 2, WS_WGATE = 24 * MiB, WS_WBR = 30 * MiB, WS_WOUT = 33 * MiB, WS_WGU2 = 35 * MiB, WS_WD2 = 46 * MiB;
constexpr size_t WS_ROPE = 56 * MiB;
constexpr size_t WS_XN = 58 * MiB;
constexpr size_t WS_BIG = 122 * MiB;
constexpr size_t WS_Y = WS_BIG + 192 * MiB;
constexpr size_t WS_OATT = WS_BIG + 240 * MiB;
constexpr size_t WS_CTL = WS_OATT + 96 * MiB;
constexpr size_t WS_L1W = 459 * MiB;
constexpr size_t WS_END = WS_L1W + 52 * MiB;
constexpr int BIGP = 3840;
constexpr int LDS_BYTES = 135168;

__device__ __forceinline__ float wave_sum(float v) {
#pragma unroll
    for (int o = 1; o < 64; o <<= 1) v += __shfl_xor(v, o);
    return v;
}
__device__ __forceinline__ unsigned pk2(float lo, float hi) { return pg8::cvt_pk_bf16(lo, hi); }

template <int MAP> __device__ __forceinline__ int rowmap(int c) {
    if constexpr (MAP == 1) { return c < FF ? ((c >> 7) * 256 + (c & 127)) : ((((c - FF) >> 7) * 256) + 128 + ((c - FF) & 127)); }
    else if constexpr (MAP == 2) { const int head = c >> 6, d = c & 63, hi = d >> 5, dd = d & 31, w2 = dd >> 4, j = dd & 15; return head * 64 + w2 * 32 + hi * 16 + j; }
    else return c;
}
template <int MAP> __device__ __forceinline__ void transpose_item(const float* __restrict__ W, int ldn, int ncol0, int nblk, bf16* __restrict__ WT, int ldk, int koff, int row_off, float* scr, int item, int lane, int ncopies) {
    const int kb = item / nblk, nb = item % nblk, k0 = 64 * kb, n0 = 32 * nb;
    float wv[32];
#pragma unroll
    for (int i = 0; i < 32; ++i) wv[i] = W[(size_t)(k0 + 2 * i + (lane >> 5)) * ldn + ncol0 + n0 + (lane & 31)];
#pragma unroll
    for (int i = 0; i < 32; ++i) scr[(2 * i + (lane >> 5)) * 33 + (lane & 31)] = wv[i];
    asm volatile("s_waitcnt lgkmcnt(0)" ::: "memory");
    const int c = lane & 7;
#pragma unroll
    for (int j = 0; j < 4; ++j) { const int n = (lane >> 3) + 8 * j; const float* s = scr + (8 * c) * 33 + n;
        v4u o; o.x = pk2(s[0 * 33], s[1 * 33]); o.y = pk2(s[2 * 33], s[3 * 33]); o.z = pk2(s[4 * 33], s[5 * 33]); o.w = pk2(s[6 * 33], s[7 * 33]);
        bf16* dst = WT + (size_t)(row_off + rowmap<MAP>(n0 + n)) * ldk + koff + k0 + 8 * c;
        for (int cp = 0; cp < ncopies; ++cp) *(v4u*)(dst + (size_t)cp * 1024) = o; }
    asm volatile("s_waitcnt lgkmcnt(0)" ::: "memory");
}

struct Args {
    unsigned long long in[22];
    unsigned long long out, ws;
    int step_lo, step_hi;
};
typedef const __attribute__((address_space(4))) Args* KArgP;
#define AIN(a, i) ((const float*)(GASQ const float*)((a)->in[i]))
#define AOUT(a) ((float*)(GASQ float*)((a)->out))
#define AWS(a) ((unsigned char*)(GASQ unsigned char*)((a)->ws))

__device__ __forceinline__ void convert_weights(KArgP a, int l, float* scr, int gw, int NGW, int lane) {
    unsigned char* ws = AWS(a) + (l ? WS_L1W : 0);
    const float* gu1 = AIN(a, 2) + (size_t)l * D * 2 * FF; const float* d1 = AIN(a, 3) + (size_t)l * FF * D;
    const float* win = AIN(a, 6) + (size_t)l * D * INCOLS; const float* wbr = AIN(a, 14) + (size_t)l * 3 * 512 * D; const float* wout = AIN(a, 16) + (size_t)l * D * D;
    const float* gu2 = AIN(a, 19) + (size_t)l * D * 2 * FF; const float* d2 = AIN(a, 20) + (size_t)l * FF * D;
    constexpr int I_GU = (D / 64) * (2 * FF / 32), I_D = (FF / 64) * (D / 32), I_QKV = (D / 64) * (NQKV / 32), I_G = (D / 64) * (NGATE / 32), I_BR = (512 / 64) * (D / 32), I_O = (D / 64) * (D / 32);
    constexpr int NITEMS = 2 * I_GU + 2 * I_D + I_QKV + I_G + 3 * I_BR + I_O;
    for (int it = gw; it < NITEMS; it += NGW) {
        int r = it;
        if (r < I_GU) { transpose_item<1>(gu1, 2 * FF, 0, 2 * FF / 32, (bf16*)(ws + WS_WGU1), D, 0, 0, scr, r, lane, 1); continue; } r -= I_GU;
        if (r < I_GU) { transpose_item<1>(gu2, 2 * FF, 0, 2 * FF / 32, (bf16*)(ws + WS_WGU2), D, 0, 0, scr, r, lane, 1); continue; } r -= I_GU;
        if (r < I_D) { transpose_item<0>(d1, D, 0, D / 32, (bf16*)(ws + WS_WD1), FF, 0, 0, scr, r, lane, 1); continue; } r -= I_D;
        if (r < I_D) { transpose_item<0>(d2, D, 0, D / 32, (bf16*)(ws + WS_WD2), FF, 0, 0, scr, r, lane, 1); continue; } r -= I_D;
        if (r < I_QKV) { transpose_item<2>(win, INCOLS, 0, NQKV / 32, (bf16*)(ws + WS_WQKV), D, 0, 0, scr, r, lane, 1); continue; } r -= I_QKV;
        if (r < I_G) { transpose_item<0>(win, INCOLS, NQKV, NGATE / 32, (bf16*)(ws + WS_WGATE), D, 0, 0, scr, r, lane, 1); continue; } r -= I_G;
        if (r < 3 * I_BR) { const int br = r / I_BR; transpose_item<0>(wbr + (size_t)br * 512 * D, D, 0, D / 32, (bf16*)(ws + WS_WBR), 512, 0, br * D, scr, r % I_BR, lane, 1); continue; } r -= 3 * I_BR;
        transpose_item<0>(wout, D, 0, D / 32, (bf16*)(ws + WS_WOUT), D, 0, 0, scr, r, lane, 1);
    }
}

__device__ __forceinline__ void row_phase(const float* hin, float* hout, const float* Y, const float* gpost, float coef,
                                          const float* gnext, bf16* XN, int gw, int NGW, int lane) {
    f32x4 gp[4], gn[4];
#pragma unroll
    for (int j = 0; j < 4; ++j) { gp[j] = Y ? *((const f32x4*)gpost + lane + 64 * j) : (f32x4){0.f, 0.f, 0.f, 0.f}; gn[j] = gnext ? *((const f32x4*)gnext + lane + 64 * j) : (f32x4){0.f, 0.f, 0.f, 0.f}; }
    for (int t_ = 0; t_ < 8; ++t_) {
        int m[2];
#pragma unroll
        for (int q = 0; q < 2; ++q) { const int tt = t_ + 8 * q;
            m[q] = (NGW < 0) ? ((((q == 0) ? (gw >> 16) : (gw >> 16) + 8) << 8) + (gw & 0xffff) + t_) : (gw + tt * NGW); }
        f32x4 v[2][4]; v2u yw[2][4];
#pragma unroll
        for (int q = 0; q < 2; ++q) { const int mm = m[q] < M ? m[q] : 0;
            const f32x4* hr = (const f32x4*)(hin + (size_t)mm * D) + lane;
#pragma unroll
            for (int j = 0; j < 4; ++j) v[q][j] = hr[64 * j];
            if (Y) { const v2u* yr = (const v2u*)((const bf16*)Y + (size_t)mm * D) + lane;
#pragma unroll
                for (int j = 0; j < 4; ++j) yw[q][j] = yr[64 * j]; } }
#pragma unroll
        for (int q = 0; q < 2; ++q) {
            if (m[q] >= M) continue;
            if (Y) {
                f32x4 y[4]; float s = 0.f;
#pragma unroll
                for (int j = 0; j < 4; ++j) { const v2u w = yw[q][j]; y[j] = (f32x4){pg8::bf_lo(w.x), pg8::bf_hi(w.x), pg8::bf_lo(w.y), pg8::bf_hi(w.y)}; s += (y[j].x * y[j].x + y[j].y * y[j].y) + (y[j].z * y[j].z + y[j].w * y[j].w); }
                const float r = coef * __builtin_amdgcn_rsqf(wave_sum(s) * (1.f / D) + EPS);
#pragma unroll
                for (int j = 0; j < 4; ++j) v[q][j] = v[q][j] + y[j] * gp[j] * r;
                f32x4* ho = (f32x4*)(hout + (size_t)m[q] * D) + lane;
#pragma unroll
                for (int j = 0; j < 4; ++j) ho[64 * j] = v[q][j];
            }
            if (gnext) {
                float s2 = 0.f;
#pragma unroll
                for (int j = 0; j < 4; ++j) s2 += (v[q][j].x * v[q][j].x + v[q][j].y * v[q][j].y) + (v[q][j].z * v[q][j].z + v[q][j].w * v[q][j].w);
                const float r2 = __builtin_amdgcn_rsqf(wave_sum(s2) * (1.f / D) + EPS);
                unsigned long long* o8 = (unsigned long long*)(XN + (size_t)m[q] * D) + lane;
#pragma unroll
                for (int j = 0; j < 4; ++j) { const f32x4 t = v[q][j] * gn[j] * r2;
                    o8[64 * j] = (unsigned long long)pk2(t.x, t.y) | ((unsigned long long)pk2(t.z, t.w) << 32); }
            }
        }
    }
}

#ifndef ATTMASK
#define ATTMASK 7
#endif
template <int AMODE> __device__ __forceinline__ void attention_phase(KArgP a, int l, char* lds, int vcu, int G) {
    using namespace att;
    const int tid = opaque_tid(), wid = tid >> 6, lane = tid & 63, r32 = lane & 31, hi = lane >> 5;
    const bf16* QKV = (const bf16*)(AWS(a) + WS_BIG);
    bf16* OA = (bf16*)(AWS(a) + WS_OATT); bf16* OB = OA + (size_t)M * 512; bf16* OC = OB + (size_t)M * 512;
    float* wsf = (float*)(lds + OFF_WS) + wid * 64;
    float lam = 0.f, lam_init = 0.f;
    if constexpr (AMODE == 0) { const float q1 = AIN(a, 9)[l * 64 + lane], k1 = AIN(a, 10)[l * 64 + lane], q2 = AIN(a, 11)[l * 64 + lane], k2 = AIN(a, 12)[l * 64 + lane];
      lam_init = 0.8f - 0.6f * __expf(-0.3f * (float)l);
      lam = __expf(wave_sum(q1 * k1)) - __expf(wave_sum(q2 * k2)) + lam_init; }
    if constexpr (AMODE == 0)
    for (int u = vcu; u < 1024; u += G) {
        const int bh = u >> 6, qb = u & 63, b = bh >> 2, h = bh & 3, t = wid >> 2;
        const long tok0 = (long)b * S + qb * 128;
        const bf16* Qw = QKV + (tok0 + (wid & 3) * 32 + r32) * LDQKV + 2304 + h * 128 + t * 64 + hi * 8;
        const bf16* Kt = QKV + (long)b * S * LDQKV + 2816 + h * 128;
        const bf16* Vt = QKV + (long)b * S * LDQKV + 3328 + h * 128;
        f32x16 o[4]; float m_reg, l_reg; ModC md{0};
        attn_loop<128, 128, 2, ModC>(Qw, Kt, Vt, S / 64, t * 128, lds, md, o, m_reg, l_reg);
        if (hi == 0) wsf[r32] = l_reg;
        asm volatile("s_waitcnt lgkmcnt(0)" ::: "memory");
        float rli[16];
#pragma unroll
        for (int r = 0; r < 16; ++r) rli[r] = __builtin_amdgcn_rcpf(wsf[crow(r, hi)]);
        __syncthreads();
        float* ex = (float*)lds + ((wid & 3) * 64) * 64 + lane;
        if (t == 1) {
#pragma unroll
            for (int d0 = 0; d0 < 4; ++d0)
#pragma unroll
                for (int r = 0; r < 16; ++r) ex[(d0 * 16 + r) * 64] = o[d0][r] * rli[r];
        }
        __syncthreads();
        if (t == 0) {
            const float* gsub = AIN(a, 13) + l * 128;
            float gg[4];
#pragma unroll
            for (int d0 = 0; d0 < 4; ++d0) gg[d0] = gsub[d0 * 32 + r32] * (1.0f - lam_init);
#pragma unroll
            for (int r = 0; r < 16; ++r) {
                float dv[4]; float ss = 0.f;
#pragma unroll
                for (int d0 = 0; d0 < 4; ++d0) { dv[d0] = o[d0][r] * rli[r] - lam * ex[(d0 * 16 + r) * 64]; ss += dv[d0] * dv[d0]; }
                ss += __shfl_xor(ss, 1); ss += __shfl_xor(ss, 2); ss += __shfl_xor(ss, 4); ss += __shfl_xor(ss, 8); ss += __shfl_xor(ss, 16);
                const float rn = __builtin_amdgcn_rsqf(ss * (1.f / 128.f) + EPS);
                bf16* op = OC + (tok0 + (wid & 3) * 32 + crow(r, hi)) * 512 + h * 128 + r32;
#pragma unroll
                for (int d0 = 0; d0 < 4; ++d0) op[d0 * 32] = (bf16)(pk2(dv[d0] * rn * gg[d0], 0.f) & 0xffffu);
            }
        }
        __syncthreads();
    }
    if constexpr (AMODE == 1)
    for (int u = vcu; u < 1024; u += G) {
        const int bh = u >> 5, qb = u & 31, b = bh >> 3, h = bh & 7;
        const long tok0 = (long)b * S + qb * 256;
        const int t0 = (4 * qb - 4) < 0 ? 0 : (4 * qb - 4), t1 = (4 * qb + 8) > 128 ? 128 : (4 * qb + 8);
        { const float* rp = AIN(a, 7) + ((size_t)l * 8 + h) * 465; float* tb = (float*)(lds + OFF_RPB); if (tid < 465) tb[tid] = rp[tid] * 8.0f; }
        const int qtok = qb * 256 + wid * 32 + r32;
        ModA md; md.qrow = qtok >> 6; md.qc = qtok & 63; md.cs = (md.qc - 8) < 0 ? 0 : ((md.qc - 8) > 48 ? 48 : (md.qc - 8)); md.rs = (md.qrow - 4) < 0 ? 0 : ((md.qrow - 4) > 120 ? 120 : (md.qrow - 4));
        md.rs = __builtin_amdgcn_readfirstlane(md.rs); md.t0 = t0; md.rpb = (const float*)(lds + OFF_RPB);
        const bf16* Qw = QKV + (tok0 + wid * 32 + r32) * LDQKV + 0 + h * 64 + hi * 8;
        const bf16* Kt = QKV + ((long)b * S + t0 * 64) * LDQKV + 512 + h * 64;
        const bf16* Vt = QKV + ((long)b * S + t0 * 64) * LDQKV + 1024 + h * 64;
        f32x16 o[2]; float m_reg, l_reg;
        attn_loop<64, 64, 0, ModA>(Qw, Kt, Vt, t1 - t0, 0, lds, md, o, m_reg, l_reg);
        if (hi == 0) wsf[r32] = l_reg;
        asm volatile("s_waitcnt lgkmcnt(0)" ::: "memory");
#pragma unroll
        for (int r = 0; r < 16; ++r) { const float rl = __builtin_amdgcn_rcpf(wsf[crow(r, hi)]);
            bf16* op = OA + (tok0 + wid * 32 + crow(r, hi)) * 512 + h * 64 + r32;
#pragma unroll
            for (int d0 = 0; d0 < 2; ++d0) op[d0 * 32] = (bf16)(pk2(o[d0][r] * rl, 0.f) & 0xffffu); }
        __syncthreads();
    }
    if constexpr (AMODE == 2)
    for (int u = vcu; u < 1024; u += G) {
        const int bh = u >> 5, qb = u & 31, b = bh >> 3, h = bh & 7, kvh = h >> 2;
        const long tok0 = (long)b * S + qb * 256;
        const int k0 = (qb * 256 - 128) < 0 ? 0 : (qb * 256 - 128), k1 = (qb * 256 + 384) > S ? S : (qb * 256 + 384);
        ModB md; md.d0 = k0 - (qb * 256 + wid * 32 + r32) + 4 * hi;
        { const int qmin = qb * 256 + __builtin_amdgcn_readfirstlane(wid) * 32; md.lo = qmin - 128 - k0; md.hi = qmin + 31 + 128 - k0; }
        const bf16* Qw = QKV + (tok0 + wid * 32 + r32) * LDQKV + 1536 + h * 64 + hi * 8;
        const bf16* Kt = QKV + ((long)b * S + k0) * LDQKV + 2048 + kvh * 64;
        const bf16* Vt = QKV + ((long)b * S + k0) * LDQKV + 2176 + kvh * 64;
        f32x16 o[2]; float m_reg, l_reg;
        attn_loop<64, 64, 1, ModB>(Qw, Kt, Vt, (k1 - k0) / 64, 0, lds, md, o, m_reg, l_reg);
        l_reg += __expf(AIN(a, 8)[l * 8 + h] - SCALE * m_reg);
        if (hi == 0) wsf[r32] = l_reg;
        asm volatile("s_waitcnt lgkmcnt(0)" ::: "memory");
#pragma unroll
        for (int r = 0; r < 16; ++r) { const float rl = __builtin_amdgcn_rcpf(wsf[crow(r, hi)]);
            bf16* op = OB + (tok0 + wid * 32 + crow(r, hi)) * 512 + h * 64 + r32;
#pragma unroll
            for (int d0 = 0; d0 < 2; ++d0) op[d0 * 32] = (bf16)(pk2(o[d0][r] * rl, 0.f) & 0xffffu); }
        __syncthreads();
    }
}

#ifndef PHMASK
#define PHMASK 0xffff
#endif
#define PH(b) if constexpr ((PHMASK >> (b)) & 1)
template <int KIND>
__global__ void __launch_bounds__(NWAVES * 64, 2) fwd_megakernel(Args a_unused) {
    constexpr bool ALL = KIND < 0;
    extern __shared__ __attribute__((aligned(16))) unsigned char lds[];
    cg::grid_group grid = cg::this_grid();
    KArgP ap0 = (KArgP)__builtin_amdgcn_kernarg_segment_ptr();
#define ARGS() ({ KArgP p_ = ap0; asm volatile("" : "+s"(p_)); p_; })
    const int G0 = gridDim.x, bx0 = blockIdx.x;
    PG8_LAS unsigned char* ldsL = (PG8_LAS unsigned char*)lds;

    const int step_lo = ARGS()->step_lo, step_hi = ARGS()->step_hi;
    if ((ALL || KIND == 9) && step_lo < 0) {
        KArgP a = ARGS(); const int G = G0, bx = bx0;
        const int tid = threadIdx.x, lane = tid & 63, wave = __builtin_amdgcn_readfirstlane(tid >> 6);
        const int gw = bx * NWAVES + wave, NGW = G * NWAVES;
        float* scr = (float*)lds + wave * (64 * 33);
        float* cosT = (float*)(AWS(a) + WS_ROPE); float* sinT = cosT + 8192 * 32;
        if (bx == 0 && tid < 64) { ((unsigned*)(AWS(a) + WS_CTL))[tid * 64] = 0u; ((unsigned*)(AWS(a) + WS_CTL))[tid * 64 + 1] = 0u; }
        PH(0) { convert_weights(a, 0, scr, gw, NGW, lane); convert_weights(a, 1, scr, gw, NGW, lane); }
        for (int i = bx * 512 + tid; i < 8192 * 32; i += G * 512) { const int pos = i >> 5, d = i & 31; const float inv = exp2f(-(float)d * (13.287712379549449f / 32.0f)); const float ang = (float)pos * inv; float sn, cs; sincosf(ang, &sn, &cs); cosT[i] = cs; sinT[i] = sn; }
        PH(1) row_phase(AIN(a, 0), nullptr, nullptr, nullptr, 0.f, AIN(a, 1), (bf16*)(AWS(a) + WS_XN), gw, NGW, lane);
        __syncthreads();
        if (step_hi > 0) gsync(grid);
    }

    constexpr int NS = 14;
    unsigned gtarget = 0u, gsame = 0u;
#ifndef MAXSTEP
#define MAXSTEP (14 * DEPTH)
#endif
    for (int step = (step_lo < 0 ? 0 : step_lo); step < step_hi; ++step) {
#ifdef DBG_DUMP
        if ((ALL || KIND == 10) && step == MAXSTEP) {
            KArgP a = ARGS(); float* o = AOUT(a); const bf16* src = (const bf16*)(AWS(a) + (size_t)DBG_DUMP_MIB * MiB);
            const unsigned t0_ = (unsigned)bx0 * 512u + (unsigned)opaque_tid();
#pragma nounroll
            for (unsigned i = t0_; i < (unsigned)(M * D); i += (unsigned)G0 * 512u) {
                float v = (DBG_DUMP_N == 0) ? ((const float*)src)[i] : ((i < (unsigned)DBG_DUMP_LIMIT) ? __uint_as_float((unsigned)src[i] << 16) : 0.f);
                if (DBG_DUMP_N > 1) v += __uint_as_float((unsigned)src[(size_t)i + DBG_DUMP_STRIDE] << 16);
                if (DBG_DUMP_N > 2) v += __uint_as_float((unsigned)src[(size_t)i + 2 * DBG_DUMP_STRIDE] << 16);
                o[i] = v; }
            break;
        }
#endif
        const int l = step / NS, sidx = step % NS;
        const int G = opaque_s(G0), bx = opaque_s(bx0);
        const bool grp = (G == 256);
        if (step == 0 && grp && threadIdx.x == 0)
            __hip_atomic_fetch_or((unsigned*)(AWS(ARGS()) + WS_CTL) + (((bx & 7) * 8 + ((bx >> 3) & 7)) * 64) + 1, 1u << ((unsigned)__builtin_amdgcn_s_getreg((3 << 11) | 20) & 0xFu), __ATOMIC_RELAXED, __HIP_MEMORY_SCOPE_AGENT);
        KArgP a = ARGS();
        unsigned char* ws = AWS(a); unsigned char* wsw = ws + (l ? WS_L1W : 0);
        bf16* XN = (bf16*)(ws + WS_XN); bf16* BIG = (bf16*)(ws + WS_BIG); float* Y = (float*)(ws + WS_Y);
        if ((ALL || KIND == 0) && (sidx == 0 || sidx == 11)) {
            PH(2) { pg8::Gemm g{XN, (const bf16*)(wsw + (sidx == 0 ? WS_WGU1 : WS_WGU2)), M, 2 * FF, D, 1 << 30, 0}; pg8::StaticOrder So; So.init(M, 2 * FF, G, bx);
              pg8::EpiSwiGLU E{BIG, BIGP}; pg8::gemm_phase<pg8::EpiSwiGLU, pg8::StaticOrder, true, true>(ldsL, g, So, E); }
        } else if ((ALL || KIND == 1) && (sidx == 1 || sidx == 9 || sidx == 12)) {
            PH(3) { const int K = (sidx == 9) ? D : FF; const size_t wo = (sidx == 1) ? WS_WD1 : (sidx == 9 ? WS_WOUT : WS_WD2);
              pg8::Gemm g{BIG, (const bf16*)(wsw + wo), M, D, K, 1 << 30, 0, BIGP}; pg8::StaticOrder So; So.init(M, D, G, bx);
              pg8::EpiY16 E{XN, D}; pg8::gemm_phase<pg8::EpiY16, pg8::StaticOrder, true, true>(ldsL, g, So, E); }
        } else if ((ALL || KIND == 2) && (sidx == 2 || sidx == 10 || sidx == 13)) {
            PH(1) { const int tid = opaque_tid(), lane = tid & 63, wave = __builtin_amdgcn_readfirstlane(tid >> 6);
              const int gw = grp ? ((((bx & 7) * 16 + ((bx >> 3) & 7)) << 16) | ((bx >> 6) * 64 + wave * 8)) : (bx * NWAVES + wave), NGW = grp ? -1 : G * NWAVES;
              const float* hin = (step == 2) ? AIN(a, 0) : AOUT(a);
              const float* gpost = AIN(a, sidx == 2 ? 4 : (sidx == 10 ? 17 : 21)) + l * D; const float coef = (sidx == 10) ? 1.0f : 0.5f;
              const float* gnext = (sidx == 2) ? AIN(a, 5) + l * D : (sidx == 10 ? AIN(a, 18) + l * D : (l + 1 < DEPTH ? AIN(a, 1) + (l + 1) * D : nullptr));
              row_phase(hin, AOUT(a), (const float*)XN, gpost, coef, gnext, XN, gw, NGW, lane); }
        } else if ((ALL || KIND == 3) && sidx == 3) {
            PH(4) { const float* cosT = (const float*)(ws + WS_ROPE); pg8::Gemm g{XN, (const bf16*)(wsw + WS_WQKV), M, NQKV, D, 1 << 30, 0}; pg8::StaticOrder So; So.init(M, NQKV, G, bx);
              pg8::EpiQKV E{BIG, NQKV, cosT, cosT + 8192 * 32}; pg8::gemm_phase<pg8::EpiQKV, pg8::StaticOrder, true, true>(ldsL, g, So, E); }
        } else if ((ALL || KIND == 4) && sidx == 4) {
            PH(5) { const int vcu = (G % 8 == 0) ? (bx % 8) * (G / 8) + bx / 8 : bx; attention_phase<0>(a, l, (char*)lds, vcu, G); }
        } else if ((ALL || KIND == 5) && sidx == 5) {
            PH(8) { const int vcu = (G % 8 == 0) ? (bx % 8) * (G / 8) + bx / 8 : bx; attention_phase<1>(a, l, (char*)lds, vcu, G); }
        } else if ((ALL || KIND == 6) && sidx == 6) {
            PH(9) { const int vcu = (G % 8 == 0) ? (bx % 8) * (G / 8) + bx / 8 : bx; attention_phase<2>(a, l, (char*)lds, vcu, G); }
        } else if ((ALL || KIND == 7) && sidx == 7) {
            PH(6) { pg8::Gemm g{XN, (const bf16*)(wsw + WS_WGATE), M, NGATE, D, 1 << 30, 0}; pg8::StaticOrder So; So.init(M, NGATE, G, bx);
              pg8::EpiGate E{BIG, BIGP, AIN(a, 15) + (size_t)l * NGATE}; pg8::gemm_phase<pg8::EpiGate, pg8::StaticOrder, true, true>(ldsL, g, So, E); }
        } else if ((ALL || KIND == 8) && sidx == 8) {
            PH(7) { for (int br = 0; br < 3; ++br) {
                pg8::Gemm g{(const bf16*)(ws + WS_OATT) + (size_t)br * M * 512, (const bf16*)(wsw + WS_WBR) + (size_t)br * D * 512, M, D, 512, 1 << 30, 0, 0}; pg8::StaticOrder So; So.init(M, D, G, bx);
                pg8::EpiBranchAcc E{BIG, BIGP, br * D, br == 0}; pg8::gemm_phase<pg8::EpiBranchAcc, pg8::StaticOrder, true, true>(ldsL, g, So, E); } }
        }
        if (step + 1 < step_hi && sidx != 4 && sidx != 5) {
            if (grp && sidx != 3 && sidx != 6) group_sync((unsigned*)(AWS(ARGS()) + WS_CTL) + (((bx & 7) * 8 + ((bx >> 3) & 7)) * 64), gtarget, gsame);
            else gsync(grid);
        }
    }

#ifdef DBG_SANITIZE
    gsync(grid);
    { KArgP a = ARGS(); float* o = AOUT(a); for (size_t i = (size_t)bx0 * 512 + threadIdx.x; i < (size_t)M * D; i += (size_t)G0 * 512) { float v = o[i]; if (!(fabsf(v) < 1e30f)) o[i] = 777.f; } }
#endif
}

#ifndef MK_PER_PHASE
#define MK_PER_PHASE 0
#endif
#ifdef DBG_DUMP
#define DBG_DUMP_EXTRA 1
#else
#define DBG_DUMP_EXTRA 0
#endif
extern "C" void kernel_launch(void* const* d_in, const int* in_sizes, int n_in, void* d_out, int out_size, void* d_ws, size_t ws_size, hipStream_t stream) {
    static int grid = 0;
    if (grid == 0) {
        if (n_in != 22 || in_sizes[0] != M * D || out_size != M * D || ws_size < WS_END) { fprintf(stderr, "kernel_launch: unexpected shapes (n_in %d in0 %d out %d ws %zu, need ws >= %zu); nothing launched\n", n_in, n_in > 0 ? in_sizes[0] : -1, out_size, ws_size, (size_t)WS_END); grid = -1; return; }
        int dev = 0, cus = 0, per_cu = 0;
        if (hipGetDevice(&dev) != hipSuccess || hipDeviceGetAttribute(&cus, hipDeviceAttributeMultiprocessorCount, dev) != hipSuccess) { grid = -1; return; }
        bool okattr = true;
#define SETA(k) okattr = okattr && (hipFuncSetAttribute((const void*)fwd_megakernel<k>, hipFuncAttributeMaxDynamicSharedMemorySize, LDS_BYTES) == hipSuccess)
        SETA(-1);
#if MK_PER_PHASE
        SETA(0); SETA(1); SETA(2); SETA(3); SETA(4); SETA(5); SETA(6); SETA(7); SETA(8); SETA(9); SETA(10);
#endif
        if (!okattr) { fprintf(stderr, "kernel_launch: hipFuncSetAttribute failed\n"); grid = -1; return; }
        if (hipOccupancyMaxActiveBlocksPerMultiprocessor(&per_cu, (const void*)fwd_megakernel<-1>, NWAVES * 64, LDS_BYTES) != hipSuccess || per_cu < 1) per_cu = 1;
        (void)hipGetLastError();
        grid = cus;
    }
    if (grid < 0) return;
    Args a{};
    for (int i = 0; i < 22; ++i) a.in[i] = (unsigned long long)(uintptr_t)d_in[i];
    a.out = (unsigned long long)(uintptr_t)d_out; a.ws = (unsigned long long)(uintptr_t)d_ws;
#ifdef DBG_DUMP
#define DBG_DUMP_EXTRA 1
#else
#define DBG_DUMP_EXTRA 0
#endif
#ifndef MK_PER_PHASE
#define MK_PER_PHASE 0
#endif
#if MK_PER_PHASE
    {
        for (int s = -1; s < MAXSTEP + DBG_DUMP_EXTRA; ++s) { a.step_lo = s; a.step_hi = s + 1;
            const int sx = s < 0 ? -1 : s % 14;
            const int kind = (s < 0) ? 9 : (s == MAXSTEP && DBG_DUMP_EXTRA) ? 10 : (sx == 0 || sx == 11) ? 0 : (sx == 1 || sx == 9 || sx == 12) ? 1 : (sx == 2 || sx == 10 || sx == 13) ? 2 : sx;
#define LK(k) case k: hipLaunchKernelGGL(fwd_megakernel<k>, dim3(grid), dim3(NWAVES * 64), LDS_BYTES, stream, a); break;
            switch (kind) { LK(0) LK(1) LK(2) LK(3) LK(4) LK(5) LK(6) LK(7) LK(8) LK(9) LK(10) }
        }
    }
#else
    {
        a.step_lo = -1; a.step_hi = MAXSTEP + DBG_DUMP_EXTRA;
        void* args[] = {&a};
        hipError_t e = hipLaunchCooperativeKernel((const void*)fwd_megakernel<-1>, dim3(grid), dim3(NWAVES * 64), args, LDS_BYTES, stream);
        if (e != hipSuccess) fprintf(stderr, "kernel_launch: cooperative launch failed: %s (grid %d)\n", hipGetErrorString(e), grid);
    }
#endif
}
```

```cpp
#include <hip/hip_runtime.h>
#include <hip/hip_cooperative_groups.h>
#include <cstdio>
#include <cstdint>
namespace cg = cooperative_groups;

__device__ __forceinline__ int opaque_tid() { int t = threadIdx.x; asm volatile("" : "+v"(t)); return t; }
__device__ __forceinline__ int opaque_s(int x) { asm volatile("" : "+s"(x)); return x; }

#define GASQ __attribute__((address_space(1)))
template <class T> __device__ __forceinline__ T* as_global(T* p) { return (T*)(GASQ T*)p; }
__device__ __forceinline__ void gsync(cg::grid_group& g) {
    asm volatile("s_waitcnt vmcnt(0)" ::: "memory");
    g.sync();
    if (threadIdx.x < 64) {
        __builtin_amdgcn_fence(__ATOMIC_ACQUIRE, "agent");
        asm volatile("s_waitcnt vmcnt(0)" ::: "memory");
    }
    __syncthreads();
}

__device__ __forceinline__ void group_sync(unsigned* cnt, unsigned& target, unsigned& same_xcd) {
    asm volatile("s_waitcnt vmcnt(0)" ::: "memory");
    __syncthreads();
    target += 4u;
    if (threadIdx.x < 64) {
        if (!same_xcd) { __builtin_amdgcn_fence(__ATOMIC_RELEASE, "agent"); asm volatile("s_waitcnt vmcnt(0)" ::: "memory"); }
        if (threadIdx.x == 0) __hip_atomic_fetch_add(cnt, 1u, __ATOMIC_RELAXED, __HIP_MEMORY_SCOPE_AGENT);
        while (__hip_atomic_load(cnt, __ATOMIC_RELAXED, __HIP_MEMORY_SCOPE_AGENT) < target) __builtin_amdgcn_s_sleep(2);
        __builtin_amdgcn_fence(__ATOMIC_ACQUIRE, "agent");
        asm volatile("s_waitcnt vmcnt(0)" ::: "memory");
        const unsigned mask = __hip_atomic_load(cnt + 1, __ATOMIC_RELAXED, __HIP_MEMORY_SCOPE_AGENT);
        same_xcd = (__builtin_popcount(mask) == 1) ? 1u : 0u;
    }
    __syncthreads();
}

__device__ __forceinline__ void set_sync(unsigned* cnt, unsigned& target) {
    asm volatile("s_waitcnt vmcnt(0)" ::: "memory");
    __syncthreads();
    target += 64u;
    if (threadIdx.x < 64) {
        __builtin_amdgcn_fence(__ATOMIC_RELEASE, "agent"); asm volatile("s_waitcnt vmcnt(0)" ::: "memory");
        if (threadIdx.x == 0) __hip_atomic_fetch_add(cnt, 1u, __ATOMIC_RELAXED, __HIP_MEMORY_SCOPE_AGENT);
        while (__hip_atomic_load(cnt, __ATOMIC_RELAXED, __HIP_MEMORY_SCOPE_AGENT) < target) __builtin_amdgcn_s_sleep(2);
        __builtin_amdgcn_fence(__ATOMIC_ACQUIRE, "agent");
        asm volatile("s_waitcnt vmcnt(0)" ::: "memory");
    }
    __syncthreads();
}

namespace pg8 {
#define PG8_LAS __attribute__((address_space(3)))
typedef unsigned short bf16_t;
typedef short bf16x8 __attribute__((ext_vector_type(8)));
typedef float f32x4 __attribute__((ext_vector_type(4)));
typedef unsigned u32x4 __attribute__((ext_vector_type(4)));
constexpr int BM = 256, BK = 64, HALF = 128, HTB = HALF * BK * 2  , STAGE_BYTES = 8 * HTB, NXCD = 8, WGM = 8;

__host__ __device__ __forceinline__ int lds_byte(int r, int c) { const int st = (r >> 4) * 2 + (c >> 5), rr = r & 15, cc = c & 31, ob = rr * 64 + cc * 2; return st * 1024 + (ob ^ (((ob >> 9) & 1) << 5)); }
__host__ __device__ __forceinline__ void stage_rc(int b, int& R, int& C) { const int st = b / 1024, sb = b % 1024, swz = sb ^ (((sb >> 9) & 1) << 5); R = (st >> 1) * 16 + swz / 64; C = (st & 1) * 32 + (swz % 64) / 2; }
__host__ __device__ __forceinline__ int perm32(int rho) { const int n = rho >> 4, i = rho & 15; return 8 * (i >> 2) + 4 * n + (i & 3); }

struct Unit { int pm, pn; };
struct Gemm { const bf16_t* A; const bf16_t* Bt; int M, N, K; int adiv; size_t astride; int lda; };

struct StaticOrder {
    int nM, nN, nwg, G, c;
    __host__ __device__ void init(int M, int N, int G_, int c_) { nM = M / BM; nN = N / BM; nwg = nM * nN; G = G_; c = c_; }
    __host__ __device__ bool next(int i, Unit& u) const {
        const long L = (long)i * G + c; if (L >= nwg) return false;
        int wgid = (int)L; { const int q = nwg / NXCD, r = nwg % NXCD, xcd = wgid % NXCD, off = wgid / NXCD; wgid = (xcd < r ? xcd * (q + 1) : r * (q + 1) + (xcd - r) * q) + off; }
        const int nig = WGM * nN, gid = wgid / nig, fm = gid * WGM, gsz = (nM - fm) < WGM ? (nM - fm) : WGM;
        u.pm = fm + ((wgid % nig) % gsz); u.pn = (wgid % nig) / gsz; return true;
    }
    __device__ __forceinline__ void a_ready(const Unit&) const {}
    __device__ __forceinline__ void done(const Unit&) const {}
};


__device__ __forceinline__ unsigned cvt_pk_bf16(float lo, float hi) { unsigned r; asm volatile("s_nop 1\n\tv_cvt_pk_bf16_f32 %0, %1, %2" : "=v"(r) : "v"(lo), "v"(hi)); return r; }
__device__ __forceinline__ float bf_lo(unsigned w) { return __uint_as_float(w << 16); }
__device__ __forceinline__ float bf_hi(unsigned w) { return __uint_as_float(w & 0xffff0000u); }
__device__ __forceinline__ float sigmoidf_fast(float x) { return __builtin_amdgcn_rcpf(1.0f + __builtin_amdgcn_exp2f(-1.4426950408889634f * x)); }

struct EpiSwiGLU {
    static constexpr bool PERM = true, AFTER_DRAIN = false;
    bf16_t* O; int ldc;
    __device__ __forceinline__ void operator()(const f32x4 (&acc)[2][2][4][2], const Unit& u, int wr, int wc, int fr, int fq) const {
        const int row0 = u.pm * BM + wr * 64 + fr, col0 = u.pn * HALF + wc * 32 + 8 * fq;
#pragma unroll
        for (int ai = 0; ai < 2; ++ai)
#pragma unroll
            for (int m = 0; m < 4; ++m) { bf16_t* rowp = O + (size_t)(row0 + ai * HALF + m * 16) * ldc + col0;
                float v[8];
#pragma unroll
                for (int n = 0; n < 2; ++n)
#pragma unroll
                    for (int e = 0; e < 4; ++e) { const float g = acc[ai][0][m][n][e], up = acc[ai][1][m][n][e]; v[n * 4 + e] = g * sigmoidf_fast(g) * up; }
                u32x4 w; w.x = cvt_pk_bf16(v[0], v[1]); w.y = cvt_pk_bf16(v[2], v[3]); w.z = cvt_pk_bf16(v[4], v[5]); w.w = cvt_pk_bf16(v[6], v[7]);
                *(u32x4*)rowp = w; }
    }
};
struct EpiF32 {
    static constexpr bool PERM = false, AFTER_DRAIN = false;
    float* Y; int ldc;
    __device__ __forceinline__ void operator()(const f32x4 (&acc)[2][2][4][2], const Unit& u, int wr, int wc, int fr, int fq) const {
        const int row0 = u.pm * BM + wr * 64 + fr, col0 = u.pn * BM + wc * 32 + 4 * fq;
#pragma unroll
        for (int ai = 0; ai < 2; ++ai)
#pragma unroll
            for (int m = 0; m < 4; ++m) { float* rowp = Y + (size_t)(row0 + ai * HALF + m * 16) * ldc + col0;
#pragma unroll
                for (int bj = 0; bj < 2; ++bj)
#pragma unroll
                    for (int n = 0; n < 2; ++n) *(f32x4*)(rowp + bj * HALF + n * 16) = acc[ai][bj][m][n]; }
    }
};
struct EpiY16 {
    static constexpr bool PERM = true, AFTER_DRAIN = false;
    bf16_t* Y; int ldc;
    __device__ __forceinline__ void operator()(const f32x4 (&acc)[2][2][4][2], const Unit& u, int wr, int wc, int fr, int fq) const {
        const int row0 = u.pm * BM + wr * 64 + fr, col0 = u.pn * BM + wc * 32 + 8 * fq;
#pragma unroll
        for (int ai = 0; ai < 2; ++ai)
#pragma unroll
            for (int m = 0; m < 4; ++m) { bf16_t* rowp = Y + (size_t)(row0 + ai * HALF + m * 16) * ldc + col0;
#pragma unroll
                for (int bj = 0; bj < 2; ++bj) { const f32x4 v0 = acc[ai][bj][m][0], v1 = acc[ai][bj][m][1];
                    u32x4 w; w.x = cvt_pk_bf16(v0[0], v0[1]); w.y = cvt_pk_bf16(v0[2], v0[3]); w.z = cvt_pk_bf16(v1[0], v1[1]); w.w = cvt_pk_bf16(v1[2], v1[3]);
                    *(u32x4*)(rowp + bj * HALF) = w; } }
    }
};
struct EpiQKV {
    static constexpr bool PERM = false, AFTER_DRAIN = false;
    bf16_t* O; int ldc; const float* cosT; const float* sinT;
    __device__ __forceinline__ static bool is_rope(int c128) { return (c128 >= 1536 && c128 < 2176) || (c128 >= 2304 && c128 < 3328); }
    __device__ __forceinline__ void operator()(const f32x4 (&acc)[2][2][4][2], const Unit& u, int wr, int wc, int fr, int fq) const {
        typedef unsigned u32x2v __attribute__((ext_vector_type(2)));
        const int row0 = u.pm * BM + wr * 64 + fr, w2 = wc & 1, dd = 16 * w2 + 4 * fq;
        const bool r0 = is_rope(u.pn * BM), r1 = is_rope(u.pn * BM + HALF);
#pragma unroll
        for (int ai = 0; ai < 2; ++ai)
#pragma unroll
            for (int m = 0; m < 4; ++m) { const int row = row0 + ai * HALF + m * 16; const int s = row & 8191;
                f32x4 cs = (f32x4){1.f, 1.f, 1.f, 1.f}, sn = (f32x4){0.f, 0.f, 0.f, 0.f};
                if (r0 || r1) { cs = *(const f32x4*)(cosT + s * 32 + dd); sn = *(const f32x4*)(sinT + s * 32 + dd); }
#pragma unroll
                for (int bj = 0; bj < 2; ++bj) { const bool rp = bj ? r1 : r0;
                    const f32x4 x1 = acc[ai][bj][m][0], x2 = acc[ai][bj][m][1];
                    f32x4 o1 = x1, o2 = x2;
                    if (rp) { o1 = x1 * cs - x2 * sn; o2 = x2 * cs + x1 * sn; }
                    bf16_t* p = O + (size_t)row * ldc + u.pn * BM + bj * HALF + (wc >> 1) * 64 + dd;
                    u32x2v a, b; a.x = cvt_pk_bf16(o1[0], o1[1]); a.y = cvt_pk_bf16(o1[2], o1[3]); b.x = cvt_pk_bf16(o2[0], o2[1]); b.y = cvt_pk_bf16(o2[2], o2[3]);
                    *(u32x2v*)p = a; *(u32x2v*)(p + 32) = b; } }
    }
};
struct EpiGate {
    static constexpr bool PERM = true, AFTER_DRAIN = false;
    bf16_t* O; int ldc; const float* bias;
    __device__ __forceinline__ void operator()(const f32x4 (&acc)[2][2][4][2], const Unit& u, int wr, int wc, int fr, int fq) const {
        const int row0 = u.pm * BM + wr * 64 + fr, col0 = u.pn * BM + wc * 32 + 8 * fq;
        f32x4 bv[2][2];
#pragma unroll
        for (int bj = 0; bj < 2; ++bj)
#pragma unroll
            for (int n = 0; n < 2; ++n) bv[bj][n] = *(const f32x4*)(bias + col0 + bj * HALF + 4 * n);
#pragma unroll
        for (int ai = 0; ai < 2; ++ai)
#pragma unroll
            for (int m = 0; m < 4; ++m) { bf16_t* rowp = O + (size_t)(row0 + ai * HALF + m * 16) * ldc + col0;
#pragma unroll
                for (int bj = 0; bj < 2; ++bj) { const f32x4 v0 = acc[ai][bj][m][0] + bv[bj][0], v1 = acc[ai][bj][m][1] + bv[bj][1];
                    u32x4 w; w.x = cvt_pk_bf16(sigmoidf_fast(v0[0]), sigmoidf_fast(v0[1])); w.y = cvt_pk_bf16(sigmoidf_fast(v0[2]), sigmoidf_fast(v0[3]));
                    w.z = cvt_pk_bf16(sigmoidf_fast(v1[0]), sigmoidf_fast(v1[1])); w.w = cvt_pk_bf16(sigmoidf_fast(v1[2]), sigmoidf_fast(v1[3]));
                    *(u32x4*)(rowp + bj * HALF) = w; } }
    }
};
struct EpiMulInPlace {
    static constexpr bool PERM = true, AFTER_DRAIN = false;
    bf16_t* O; int ldc;
    __device__ __forceinline__ void operator()(const f32x4 (&acc)[2][2][4][2], const Unit& u, int wr, int wc, int fr, int fq) const {
        const int row0 = u.pm * BM + wr * 64 + fr, col0 = u.pn * BM + wc * 32 + 8 * fq;
#pragma unroll
        for (int ai = 0; ai < 2; ++ai)
#pragma unroll
            for (int m = 0; m < 4; ++m) { bf16_t* rowp = O + (size_t)(row0 + ai * HALF + m * 16) * ldc + col0;
#pragma unroll
                for (int bj = 0; bj < 2; ++bj) { const u32x4 g = *(const u32x4*)(rowp + bj * HALF); const f32x4 v0 = acc[ai][bj][m][0], v1 = acc[ai][bj][m][1];
                    u32x4 w; w.x = cvt_pk_bf16(v0[0] * bf_lo(g.x), v0[1] * bf_hi(g.x)); w.y = cvt_pk_bf16(v0[2] * bf_lo(g.y), v0[3] * bf_hi(g.y));
                    w.z = cvt_pk_bf16(v1[0] * bf_lo(g.z), v1[1] * bf_hi(g.z)); w.w = cvt_pk_bf16(v1[2] * bf_lo(g.w), v1[3] * bf_hi(g.w));
                    *(u32x4*)(rowp + bj * HALF) = w; } }
    }
};
struct EpiBranchAcc {
    static constexpr bool PERM = true, AFTER_DRAIN = false;
    bf16_t* O; int ldc; int gcol0; int first;
    __device__ __forceinline__ void operator()(const f32x4 (&acc)[2][2][4][2], const Unit& u, int wr, int wc, int fr, int fq) const {
        const int row0 = u.pm * BM + wr * 64 + fr, col0 = u.pn * BM + wc * 32 + 8 * fq;
#pragma unroll
        for (int ai = 0; ai < 2; ++ai)
#pragma unroll
            for (int m = 0; m < 4; ++m) { bf16_t* rowp = O + (size_t)(row0 + ai * HALF + m * 16) * ldc + col0;
#pragma unroll
                for (int bj = 0; bj < 2; ++bj) { const u32x4 g = *(const u32x4*)(rowp + gcol0 + bj * HALF); const f32x4 v0 = acc[ai][bj][m][0], v1 = acc[ai][bj][m][1];
                    float r[8] = {v0[0] * bf_lo(g.x), v0[1] * bf_hi(g.x), v0[2] * bf_lo(g.y), v0[3] * bf_hi(g.y), v1[0] * bf_lo(g.z), v1[1] * bf_hi(g.z), v1[2] * bf_lo(g.w), v1[3] * bf_hi(g.w)};
                    if (!first) { const u32x4 p = *(const u32x4*)(rowp + bj * HALF);
                        r[0] += bf_lo(p.x); r[1] += bf_hi(p.x); r[2] += bf_lo(p.y); r[3] += bf_hi(p.y); r[4] += bf_lo(p.z); r[5] += bf_hi(p.z); r[6] += bf_lo(p.w); r[7] += bf_hi(p.w); }
                    u32x4 w; w.x = cvt_pk_bf16(r[0], r[1]); w.y = cvt_pk_bf16(r[2], r[3]); w.z = cvt_pk_bf16(r[4], r[5]); w.w = cvt_pk_bf16(r[6], r[7]);
                    *(u32x4*)(rowp + bj * HALF) = w; } }
    }
};

template <class Epi, class Sched, bool ALIGN_EPI = false, bool SP2 = false>
__device__ __forceinline__ void gemm_phase(PG8_LAS unsigned char* lds, const Gemm g, const Sched& S, const Epi& E) {
    const int tid = opaque_tid(), wid = __builtin_amdgcn_readfirstlane(tid >> 6), lane = tid & 63, wr = wid >> 2, wc = wid & 3, fr = lane & 15, fq = lane >> 4;
    const int K = g.K, nt = K / BK, lda = g.lda ? g.lda : g.K;
    unsigned voffA[2], voffB[2];
#pragma unroll
    for (int i = 0; i < 2; ++i) { int R, C; stage_rc(tid * 16 + i * 8192, R, C); const int Rb = Epi::PERM ? ((R & ~31) + perm32(R & 31)) : R;
        voffA[i] = (unsigned)(R * lda + C) * 2u; voffB[i] = (unsigned)(Rb * K + C) * 2u; }
    const size_t kstep = (size_t)(BK * 2);
    const size_t hstepA = (size_t)HALF * lda * 2, tstepA = 2 * hstepA;
    const size_t hstep = (size_t)HALF * K * 2;
    const size_t tstep = 2 * hstep;
    const unsigned ldsw = (unsigned)wid * 1024u;
    const int aoff = lds_byte(wr * 64 + fr, fq * 8), boff = lds_byte(wc * 32 + fr, fq * 8);
#define PG8_SA(b, h) (((b) * 2 + (h)) * HTB)
#define PG8_SB(b, h) ((4 + (b) * 2 + (h)) * HTB)
#define PG8_STAGE(bufoff, gbase, voff) do { _Pragma("unroll") for (int _i = 0; _i < 2; ++_i) \
        __builtin_amdgcn_global_load_lds((const unsigned*)((const char*)(gbase) + (voff)[_i]), (PG8_LAS unsigned*)(lds + (bufoff) + ldsw + _i * 8192), 16, 0, 0); } while (0)
#define PG8_LDA(dst, b, h) do { _Pragma("unroll") for (int m = 0; m < 4; ++m) _Pragma("unroll") for (int k = 0; k < 2; ++k) dst[m][k] = *(const PG8_LAS bf16x8*)(lds + PG8_SA(b, h) + aoff + m * 2048 + k * 1024); } while (0)
#define PG8_LDB(dst, b, h) do { _Pragma("unroll") for (int n = 0; n < 2; ++n) _Pragma("unroll") for (int k = 0; k < 2; ++k) dst[n][k] = *(const PG8_LAS bf16x8*)(lds + PG8_SB(b, h) + boff + n * 2048 + k * 1024); } while (0)
#define PG8_MMA(ai, bj, At, Bt) do { __builtin_amdgcn_s_setprio(1); _Pragma("unroll") for (int m = 0; m < 4; ++m) _Pragma("unroll") for (int n = 0; n < 2; ++n) _Pragma("unroll") for (int k = 0; k < 2; ++k) \
        acc[ai][bj][m][n] = __builtin_amdgcn_mfma_f32_16x16x32_bf16(Bt[n][k], At[m][k], acc[ai][bj][m][n], 0, 0, 0); __builtin_amdgcn_s_setprio(0); } while (0)
#define PG8_WAIT_V(n) asm volatile("s_waitcnt vmcnt(" #n ")" ::: "memory")
#define PG8_WAIT_L(n) asm volatile("s_waitcnt lgkmcnt(" #n ")" ::: "memory")
#define PG8_BAR __builtin_amdgcn_s_barrier()
#define PG8_SCHED __builtin_amdgcn_sched_barrier(0)
    Unit cur, nxt; int ui = 0;
    if (!S.next(0, cur)) return;
    f32x4 acc[2][2][4][2];
#pragma unroll
    for (int a = 0; a < 2; ++a)
#pragma unroll
        for (int b = 0; b < 2; ++b)
#pragma unroll
            for (int m = 0; m < 4; ++m)
#pragma unroll
                for (int n = 0; n < 2; ++n) acc[a][b][m][n] = (f32x4){0.f, 0.f, 0.f, 0.f};
    bf16x8 At[4][2], B0[2][2], B1[2][2];
    const char* cA = (const char*)g.A + (size_t)cur.pm * tstepA + (size_t)(cur.pn / g.adiv) * g.astride; const char* cB = (const char*)g.Bt + (size_t)cur.pn * tstep;
    S.a_ready(cur);
    if constexpr (SP2) {
        PG8_STAGE(PG8_SB(0, 0), cB, voffB); PG8_STAGE(PG8_SB(0, 1), cB + hstep, voffB); PG8_STAGE(PG8_SA(0, 0), cA, voffA); PG8_STAGE(PG8_SA(0, 1), cA + hstepA, voffA);
        if (wr == 1) PG8_BAR;
        PG8_WAIT_V(2); PG8_BAR;
        PG8_STAGE(PG8_SB(1, 0), cB + kstep, voffB); PG8_STAGE(PG8_SA(1, 0), cA + kstep, voffA); PG8_STAGE(PG8_SB(1, 1), cB + hstep + kstep, voffB);
        PG8_WAIT_V(6); PG8_BAR;
    } else {
        PG8_STAGE(PG8_SB(0, 0), cB, voffB); PG8_STAGE(PG8_SA(0, 0), cA, voffA); PG8_STAGE(PG8_SB(0, 1), cB + hstep, voffB); PG8_STAGE(PG8_SA(0, 1), cA + hstepA, voffA);
        if (wr == 1) PG8_BAR;
        PG8_WAIT_V(4); PG8_BAR;
        PG8_STAGE(PG8_SB(1, 0), cB + kstep, voffB); PG8_STAGE(PG8_SA(1, 0), cA + kstep, voffA); PG8_STAGE(PG8_SB(1, 1), cB + hstep + kstep, voffB);
        PG8_WAIT_V(6); PG8_BAR;
    }
    for (;;) {
        const bool has_next = S.next(ui + 1, nxt);
        const char* nA = has_next ? (const char*)g.A + (size_t)nxt.pm * tstepA + (size_t)(nxt.pn / g.adiv) * g.astride : cA; const char* nB = has_next ? (const char*)g.Bt + (size_t)nxt.pn * tstep : cB;
        for (int t = 0; t < nt; t += 2) {
            const bool last = (t == nt - 2);
            const char* a1 = cA + (size_t)(t + 1) * kstep;
            const char* a2 = last ? nA : cA + (size_t)(t + 2) * kstep; const char* b2 = last ? nB : cB + (size_t)(t + 2) * kstep;
            const char* a3 = a2 + kstep; const char* b3 = b2 + kstep;
            if (last && has_next) S.a_ready(nxt);
            if constexpr (SP2) {
            PG8_LDB(B0, 0, 0); PG8_LDB(B1, 0, 1); PG8_SCHED; PG8_LDA(At, 0, 0); PG8_STAGE(PG8_SA(1, 1), a1 + hstepA, voffA);
            PG8_WAIT_V(8); PG8_WAIT_L(0); PG8_BAR; PG8_MMA(0, 0, At, B0); PG8_MMA(0, 1, At, B1); PG8_BAR; PG8_SCHED;
            PG8_LDA(At, 0, 1); PG8_STAGE(PG8_SB(0, 0), b2, voffB); PG8_STAGE(PG8_SB(0, 1), b2 + hstep, voffB); PG8_STAGE(PG8_SA(0, 0), a2, voffA);
            PG8_WAIT_V(8); PG8_WAIT_L(0); PG8_BAR; PG8_MMA(1, 0, At, B0); PG8_MMA(1, 1, At, B1); PG8_BAR; PG8_SCHED;
            PG8_LDB(B0, 1, 0); PG8_LDB(B1, 1, 1); PG8_SCHED; PG8_LDA(At, 1, 0); PG8_STAGE(PG8_SA(0, 1), a2 + hstepA, voffA);
            PG8_WAIT_V(8); PG8_WAIT_L(0); PG8_BAR; PG8_MMA(0, 0, At, B0); PG8_MMA(0, 1, At, B1); PG8_BAR; PG8_SCHED;
            PG8_LDA(At, 1, 1); PG8_STAGE(PG8_SB(1, 0), b3, voffB); PG8_STAGE(PG8_SB(1, 1), b3 + hstep, voffB); PG8_STAGE(PG8_SA(1, 0), a3, voffA);
            PG8_WAIT_V(8); PG8_WAIT_L(0); PG8_BAR; PG8_MMA(1, 0, At, B0); PG8_MMA(1, 1, At, B1); PG8_BAR; PG8_SCHED;
            } else {
            PG8_LDB(B0, 0, 0); PG8_SCHED; PG8_LDA(At, 0, 0); PG8_STAGE(PG8_SA(1, 1), a1 + hstepA, voffA);
            PG8_WAIT_L(8); PG8_BAR; PG8_WAIT_L(0); PG8_MMA(0, 0, At, B0); PG8_BAR; PG8_SCHED;
            PG8_LDB(B1, 0, 1); PG8_STAGE(PG8_SB(0, 0), b2, voffB);
            PG8_BAR; PG8_WAIT_L(0); PG8_MMA(0, 1, At, B1); PG8_BAR;
            PG8_LDA(At, 0, 1); PG8_STAGE(PG8_SA(0, 0), a2, voffA);
            PG8_BAR; PG8_WAIT_L(0); PG8_MMA(1, 0, At, B0); PG8_BAR; PG8_SCHED;
            PG8_STAGE(PG8_SB(0, 1), b2 + hstep, voffB);
            PG8_WAIT_V(6); PG8_BAR; PG8_MMA(1, 1, At, B1); PG8_BAR;
            PG8_LDB(B0, 1, 0); PG8_SCHED; PG8_LDA(At, 1, 0); PG8_STAGE(PG8_SA(0, 1), a2 + hstepA, voffA);
            PG8_WAIT_L(8); PG8_BAR; PG8_WAIT_L(0); PG8_MMA(0, 0, At, B0); PG8_BAR; PG8_SCHED;
            PG8_LDB(B1, 1, 1); PG8_STAGE(PG8_SB(1, 0), b3, voffB);
            PG8_BAR; PG8_WAIT_L(0); PG8_MMA(0, 1, At, B1); PG8_BAR;
            PG8_LDA(At, 1, 1); PG8_STAGE(PG8_SA(1, 0), a3, voffA);
            PG8_BAR; PG8_WAIT_L(0); PG8_MMA(1, 0, At, B0); PG8_BAR; PG8_SCHED;
            PG8_STAGE(PG8_SB(1, 1), b3 + hstep, voffB);
            PG8_WAIT_V(6); PG8_BAR; PG8_MMA(1, 1, At, B1); PG8_BAR;
            }
        }
        if constexpr (ALIGN_EPI) { if (wr == 0) PG8_BAR; }
        if constexpr (!Epi::AFTER_DRAIN) { E(acc, cur, wr, wc, fr, fq); S.done(cur); }
        if (!has_next) break;
#pragma unroll
        for (int a = 0; a < 2; ++a)
#pragma unroll
            for (int b = 0; b < 2; ++b)
#pragma unroll
                for (int m = 0; m < 4; ++m)
#pragma unroll
                    for (int n = 0; n < 2; ++n) acc[a][b][m][n] = (f32x4){0.f, 0.f, 0.f, 0.f};
        cur = nxt; cA = nA; cB = nB; ++ui;
        if constexpr (ALIGN_EPI) { if (wr == 1) PG8_BAR; }
    }
    PG8_WAIT_V(0);
    if constexpr (!ALIGN_EPI) { if (wr == 0) PG8_BAR; }
    PG8_BAR;
    if constexpr (Epi::AFTER_DRAIN) { E.fused(acc, cur, wr, wc, fr, fq, lds, wid, lane); S.done(cur); }
#undef PG8_SA
#undef PG8_SB
#undef PG8_STAGE
#undef PG8_LDA
#undef PG8_LDB
#undef PG8_MMA
#undef PG8_WAIT_V
#undef PG8_WAIT_L
#undef PG8_BAR
#undef PG8_SCHED
}

template <class Epi, class Sched>
__device__ __forceinline__ void gemm_plain(PG8_LAS unsigned char* lds, const Gemm g, const Sched& S, const Epi& E) {
    const int tid = opaque_tid(), wid = __builtin_amdgcn_readfirstlane(tid >> 6), lane = tid & 63, wr = wid >> 2, wc = wid & 3, fr = lane & 15, fq = lane >> 4;
    const int K = g.K, nk = K / 32;
    constexpr int PITCH = 80, TILE = 256 * PITCH;
    const int sr = tid >> 1, sh = tid & 1;
    const int srb = Epi::PERM ? ((sr & ~31) + perm32(sr & 31)) : sr;
    const size_t ga = (size_t)sr * K + sh * 16, gb = (size_t)srb * K + sh * 16;
    const int st = sr * PITCH + sh * 32;
    const int ard = (wr * 64 + fr) * PITCH + fq * 16, brd = (wc * 32 + fr) * PITCH + fq * 16;
    Unit cur;
    for (int ui = 0; S.next(ui, cur); ++ui) {
        const bf16_t* pA = g.A + (size_t)cur.pm * 256 * K + (size_t)(cur.pn / g.adiv) * (g.astride / 2) + ga;
        const bf16_t* pB = g.Bt + (size_t)cur.pn * 256 * K + gb;
        f32x4 acc[2][2][4][2];
#pragma unroll
        for (int a = 0; a < 2; ++a)
#pragma unroll
            for (int b = 0; b < 2; ++b)
#pragma unroll
                for (int m = 0; m < 4; ++m)
#pragma unroll
                    for (int n = 0; n < 2; ++n) acc[a][b][m][n] = (f32x4){0.f, 0.f, 0.f, 0.f};
        u32x4 ra0 = *(const u32x4*)(pA), ra1 = *(const u32x4*)(pA + 8), rb0 = *(const u32x4*)(pB), rb1 = *(const u32x4*)(pB + 8);
        *(PG8_LAS u32x4*)(lds + st) = ra0; *(PG8_LAS u32x4*)(lds + st + 16) = ra1;
        *(PG8_LAS u32x4*)(lds + TILE + st) = rb0; *(PG8_LAS u32x4*)(lds + TILE + st + 16) = rb1;
        __syncthreads();
        for (int kt = 0; kt < nk; ++kt) {
            const int cb = (kt & 1) * 2 * TILE, nb = ((kt + 1) & 1) * 2 * TILE;
            if (kt + 1 < nk) { ra0 = *(const u32x4*)(pA + (kt + 1) * 32); ra1 = *(const u32x4*)(pA + (kt + 1) * 32 + 8); rb0 = *(const u32x4*)(pB + (kt + 1) * 32); rb1 = *(const u32x4*)(pB + (kt + 1) * 32 + 8); }
            bf16x8 Bf[2][2];
#pragma unroll
            for (int bj = 0; bj < 2; ++bj)
#pragma unroll
                for (int n = 0; n < 2; ++n) Bf[bj][n] = *(const PG8_LAS bf16x8*)(lds + cb + TILE + brd + (bj * 128 + n * 16) * PITCH);
#pragma unroll
            for (int ai = 0; ai < 2; ++ai) {
                bf16x8 Af[4];
#pragma unroll
                for (int m = 0; m < 4; ++m) Af[m] = *(const PG8_LAS bf16x8*)(lds + cb + ard + (ai * 128 + m * 16) * PITCH);
#pragma unroll
                for (int bj = 0; bj < 2; ++bj)
#pragma unroll
                    for (int m = 0; m < 4; ++m)
#pragma unroll
                        for (int n = 0; n < 2; ++n) acc[ai][bj][m][n] = __builtin_amdgcn_mfma_f32_16x16x32_bf16(Bf[bj][n], Af[m], acc[ai][bj][m][n], 0, 0, 0);
            }
            if (kt + 1 < nk) { *(PG8_LAS u32x4*)(lds + nb + st) = ra0; *(PG8_LAS u32x4*)(lds + nb + st + 16) = ra1;
                               *(PG8_LAS u32x4*)(lds + nb + TILE + st) = rb0; *(PG8_LAS u32x4*)(lds + nb + TILE + st + 16) = rb1; }
            __syncthreads();
        }
        E(acc, cur, wr, wc, fr, fq);
    }
}
}

namespace att {
using bf16 = unsigned short;
using bf16x8 = __attribute__((ext_vector_type(8))) short;
using s16x4  = __attribute__((ext_vector_type(4))) short;
using f32x16 = __attribute__((ext_vector_type(16))) float;
using u32x4  = __attribute__((ext_vector_type(4))) unsigned;
constexpr int LDQKV = 3840;
constexpr float SCALE = 0.125f;
constexpr float THR = 8.f;
constexpr float NEGBIG = -1e30f;
constexpr float MINIT = -1e9f;
constexpr int OFF_V = 0, OFF_K = 49152, OFF_WS = 98304, OFF_RPB = 98304 + 2048, ATT_LDS = 98304 + 4096;
#define SBAR() __builtin_amdgcn_sched_barrier(0)
__device__ __forceinline__ int crow(int r, int hi) { return (r & 3) + 8 * (r >> 2) + 4 * hi; }
__device__ __forceinline__ constexpr int crow0(int r) { return (r & 3) + 8 * (r >> 2); }
__device__ __forceinline__ unsigned cvtpk(float lo, float hi) { unsigned r; asm volatile("s_nop 0\n\tv_cvt_pk_bf16_f32 %0, %1, %2" : "=v"(r) : "v"(lo), "v"(hi)); return r; }
template <int KW> __device__ __forceinline__ int kswz(int row, int colB) {
  if constexpr (KW == 128) return row * 256 + (colB ^ ((row & 7) << 4));
  else return row * 128 + (colB ^ (((row >> 1) & 7) << 4));
}
struct ModA { int qrow, qc, cs, rs, t0; const float* rpb; __device__ __forceinline__ bool need(int j) const { const int kr = t0 + j; return kr >= rs && kr < rs + 8; } };
struct ModB { int d0, lo, hi; __device__ __forceinline__ bool need(int j) const { return (64 * j + 63 >= lo) && (64 * j <= hi); } };
struct ModC { int dummy; __device__ __forceinline__ constexpr bool need(int) const { return true; } };

template <int MODE, class Mod> __device__ __forceinline__ void modify(f32x16& p0, f32x16& p1, const Mod& md, int j, int hi) {
  if constexpr (MODE == 0) {
    const int kr = md.t0 + j; const bool row_ok = (kr >= md.rs) && (kr < md.rs + 8);
    if (!row_ok) {
#pragma unroll
      for (int r = 0; r < 16; ++r) { p0[r] = NEGBIG; p1[r] = NEGBIG; }
    } else {
      const float* tb = md.rpb + (kr - md.qrow + 7) * 31;
      const int kc0 = 4 * hi - md.cs, dc0 = 4 * hi - md.qc + 15;
#pragma unroll
      for (int r = 0; r < 16; ++r) {
        { const int kc = kc0 + crow0(r); int dc = dc0 + crow0(r); dc = dc < 0 ? 0 : (dc > 30 ? 30 : dc); const float b = tb[dc]; p0[r] = ((unsigned)kc < 16u) ? p0[r] + b : NEGBIG; }
        { const int kc = kc0 + crow0(r) + 32; int dc = dc0 + crow0(r) + 32; dc = dc < 0 ? 0 : (dc > 30 ? 30 : dc); const float b = tb[dc]; p1[r] = ((unsigned)kc < 16u) ? p1[r] + b : NEGBIG; }
      }
    }
  } else if constexpr (MODE == 1) {
    const int base = md.d0 + j * 64 + 128;
#pragma unroll
    for (int r = 0; r < 16; ++r) {
      p0[r] = ((unsigned)(base + crow0(r)) <= 256u) ? p0[r] : NEGBIG;
      p1[r] = ((unsigned)(base + crow0(r) + 32) <= 256u) ? p1[r] : NEGBIG;
    }
  }
}
template <int MODE, class Mod> __device__ __forceinline__ void partialSM(f32x16& p0, f32x16& p1, float& m_reg, float& mn, float& alpha, const Mod& md, int j, int hi) {
  constexpr float C = SCALE * 1.4426950408889634f;
  modify<MODE, Mod>(p0, p1, md, j, hi);
  float pmax = p0[0];
#pragma unroll
  for (int r = 1; r < 16; ++r) pmax = fmaxf(pmax, p0[r]);
#pragma unroll
  for (int r = 0; r < 16; ++r) pmax = fmaxf(pmax, p1[r]);
  { auto rr = __builtin_amdgcn_permlane32_swap(__float_as_uint(pmax), __float_as_uint(pmax), false, false);
    pmax = fmaxf(__uint_as_float(rr[0]), __uint_as_float(rr[1])); }
  if (__builtin_expect(__all(pmax - m_reg <= THR / SCALE), 1)) { mn = m_reg; alpha = 1.f; }
  else { mn = fmaxf(m_reg, pmax); alpha = __builtin_amdgcn_exp2f((m_reg - mn) * C); m_reg = mn; }
  const float mnC = -mn * C;
#pragma unroll
  for (int r = 0; r < 16; ++r) p0[r] = fmaf(p0[r], C, mnC);
#pragma unroll
  for (int r = 0; r < 16; ++r) p1[r] = fmaf(p1[r], C, mnC);
#pragma unroll
  for (int r = 0; r < 16; ++r) p0[r] = __builtin_amdgcn_exp2f(p0[r]);
}
__device__ __forceinline__ void finishSM(f32x16& p0, f32x16& p1, float alpha, float& l_reg, bf16x8& pa0, bf16x8& pa1, bf16x8& pa2, bf16x8& pa3) {
#pragma unroll
  for (int r = 0; r < 16; ++r) p1[r] = __builtin_amdgcn_exp2f(p1[r]);
  float ps = 0;
#pragma unroll
  for (int r = 0; r < 16; ++r) ps += p0[r];
#pragma unroll
  for (int r = 0; r < 16; ++r) ps += p1[r];
  { auto rr = __builtin_amdgcn_permlane32_swap(__float_as_uint(ps), __float_as_uint(ps), false, false);
    ps = __uint_as_float(rr[0]) + __uint_as_float(rr[1]); }
  l_reg = l_reg * alpha + ps;
#define PK4(P, BASE, OUT) do { unsigned a0 = cvtpk(P[BASE + 0], P[BASE + 1]), a1 = cvtpk(P[BASE + 2], P[BASE + 3]);   \
    unsigned b0 = cvtpk(P[BASE + 4], P[BASE + 5]), b1 = cvtpk(P[BASE + 6], P[BASE + 7]);                              \
    auto r0 = __builtin_amdgcn_permlane32_swap(a0, b0, false, false); auto r1 = __builtin_amdgcn_permlane32_swap(a1, b1, false, false); \
    u32x4 w = {r0[0], r1[0], r0[1], r1[1]}; OUT = *reinterpret_cast<bf16x8*>(&w); } while (0)
  PK4(p0, 0, pa0); PK4(p0, 8, pa1); PK4(p1, 0, pa2); PK4(p1, 8, pa3);
#undef PK4
}
template <int KW> __device__ __forceinline__ void qkt(f32x16& p0, f32x16& p1, const char* Ks, const bf16x8 (&qr)[4], int r32, int hi, int kcolB) {
  p0 = f32x16{}; p1 = f32x16{};
#pragma unroll
  for (int d0 = 0; d0 < 4; ++d0) { const int cb = kcolB + (d0 * 16 + hi * 8) * 2;
    const bf16x8 b0 = *reinterpret_cast<const bf16x8*>(Ks + kswz<KW>(r32, cb));
    const bf16x8 b1 = *reinterpret_cast<const bf16x8*>(Ks + kswz<KW>(32 + r32, cb));
    p0 = __builtin_amdgcn_mfma_f32_32x32x16_bf16(b0, qr[d0], p0, 0, 0, 0);
    p1 = __builtin_amdgcn_mfma_f32_32x32x16_bf16(b1, qr[d0], p1, 0, 0, 0); }
}
template <int DV> __device__ __forceinline__ int v_st(int k, int c) { const int kk = (k & ~0xC) | ((k & 4) << 1) | ((k & 8) >> 1); return ((kk >> 3) * (DV / 32) + (c >> 5)) * 512 + ((kk & 7) * 32 + (c & 31)) * 2; }
__device__ __forceinline__ int v_rd_base(int lane) { return ((lane & 3) << 3) | (((lane >> 2) & 3) << 6) | (((lane >> 4) & 1) << 5) | (((lane >> 5) & 1) << 8); }
template <int DV> constexpr int v_rd_off(int d0, int ks, int half) { return d0 * 512 + ks * (DV / 32) * 1024 + half * (DV / 32) * 512; }
template <int OFF> __device__ __forceinline__ s16x4 tr_read(int vb) {
  s16x4 r; asm volatile("ds_read_b64_tr_b16 %0, %1 offset:%2" : "=&v"(r) : "v"(vb), "i"(OFF) : "memory"); return r;
}
template <int DV, int D0> __device__ __forceinline__ void pv_one(f32x16& od, int vb, bf16x8 pa0, bf16x8 pa1, bf16x8 pa2, bf16x8 pa3) {
  const s16x4 l0 = tr_read<v_rd_off<DV>(D0, 0, 0)>(vb), h0 = tr_read<v_rd_off<DV>(D0, 0, 1)>(vb), l1 = tr_read<v_rd_off<DV>(D0, 1, 0)>(vb), h1 = tr_read<v_rd_off<DV>(D0, 1, 1)>(vb);
  const s16x4 l2 = tr_read<v_rd_off<DV>(D0, 2, 0)>(vb), h2 = tr_read<v_rd_off<DV>(D0, 2, 1)>(vb), l3 = tr_read<v_rd_off<DV>(D0, 3, 0)>(vb), h3 = tr_read<v_rd_off<DV>(D0, 3, 1)>(vb);
  asm volatile("s_waitcnt lgkmcnt(0)" ::: "memory"); SBAR();
#define PK(L, H) (bf16x8){L[0], L[1], L[2], L[3], H[0], H[1], H[2], H[3]}
  od = __builtin_amdgcn_mfma_f32_32x32x16_bf16(pa0, PK(l0, h0), od, 0, 0, 0);
  od = __builtin_amdgcn_mfma_f32_32x32x16_bf16(pa1, PK(l1, h1), od, 0, 0, 0);
  od = __builtin_amdgcn_mfma_f32_32x32x16_bf16(pa2, PK(l2, h2), od, 0, 0, 0);
  od = __builtin_amdgcn_mfma_f32_32x32x16_bf16(pa3, PK(l3, h3), od, 0, 0, 0);
#undef PK
}
template <int DV> __device__ __forceinline__ void pv_all(f32x16 (&o)[DV / 32], int vb, bf16x8 pa0, bf16x8 pa1, bf16x8 pa2, bf16x8 pa3) {
  pv_one<DV, 0>(o[0], vb, pa0, pa1, pa2, pa3); pv_one<DV, 1>(o[1], vb, pa0, pa1, pa2, pa3);
  if constexpr (DV == 128) { pv_one<DV, 2>(o[2], vb, pa0, pa1, pa2, pa3); pv_one<DV, 3>(o[3], vb, pa0, pa1, pa2, pa3); }
}

template <int KW, int DV, int MODE, class Mod>
__device__ __forceinline__ void attn_loop(const bf16* __restrict__ Qw, const bf16* __restrict__ Kt, const bf16* __restrict__ Vt, int NT, int kcolB, char* lds, const Mod& md,
                                          f32x16 (&o)[DV / 32], float& m_reg, float& l_reg) {
  constexpr int SHM_V = 64 * DV * 2, SHM_K = 64 * KW * 2, NKL = KW / 64, NVL = DV / 64;
  const int tid = opaque_tid(), wid = tid >> 6, lane = tid & 63, r32 = lane & 31, hi = lane >> 5;
  char* V_lds = lds + OFF_V; char* K_lds = lds + OFF_K;
  float* al_l = (float*)(lds + OFF_WS) + wid * 64 + 32;
  m_reg = MINIT; l_reg = 0.f;
#pragma unroll
  for (int d = 0; d < DV / 32; ++d) o[d] = f32x16{};
  bf16x8 qr[4];
#pragma unroll
  for (int d0 = 0; d0 < 4; ++d0) qr[d0] = *reinterpret_cast<const bf16x8*>(Qw + d0 * 16);
  const int ksr = (KW == 128) ? (tid >> 4) : (tid >> 3), ksc = (KW == 128) ? (tid & 15) * 8 : (tid & 7) * 8;
  const int vsr = (DV == 128) ? (tid >> 4) : (tid >> 3), vsc = (DV == 128) ? (tid & 15) * 8 : (tid & 7) * 8;
  const int vst0 = v_st<DV>(vsr, vsc), vst1 = v_st<DV>(32 + vsr, vsc);
  const int kst0 = kswz<KW>(ksr, ksc * 2), kst1 = kswz<KW>(32 + ksr, ksc * 2);
  const int vb0 = (int)(uintptr_t)V_lds + v_rd_base(lane);
  const bf16* Kp = Kt + (long)ksr * LDQKV + ksc; const bf16* Vp = Vt + (long)vsr * LDQKV + vsc;
  bf16x8 sK[NKL], sV[NVL];
#define SLOAD(k0) do { _Pragma("unroll") for (int q_ = 0; q_ < NVL; ++q_) sV[q_] = *reinterpret_cast<const bf16x8*>(Vp + (long)((k0) + 32 * q_) * LDQKV); \
    _Pragma("unroll") for (int q_ = 0; q_ < NKL; ++q_) sK[q_] = *reinterpret_cast<const bf16x8*>(Kp + (long)((k0) + 32 * q_) * LDQKV); } while (0)
#define SWRITE(b) do { *(bf16x8*)(V_lds + (b) * SHM_V + vst0) = sV[0]; if constexpr (NVL == 2) *(bf16x8*)(V_lds + (b) * SHM_V + vst1) = sV[NVL - 1]; \
    *(bf16x8*)(K_lds + (b) * SHM_K + kst0) = sK[0]; if constexpr (NKL == 2) *(bf16x8*)(K_lds + (b) * SHM_K + kst1) = sK[NKL - 1]; } while (0)
#define RESC(a) do { if (__any((a) < 1.f)) { if (hi == 0) al_l[r32] = (a); asm volatile("s_waitcnt lgkmcnt(0)" ::: "memory"); \
    _Pragma("unroll") for (int d = 0; d < DV / 32; ++d) _Pragma("unroll") for (int r = 0; r < 16; ++r) o[d][r] *= al_l[crow(r, hi)]; } } while (0)
  f32x16 pA0, pA1, pB0, pB1; float mnA, mnB, alA, alB; bf16x8 pa0, pa1, pa2, pa3;
  SLOAD(0); SWRITE(0); SLOAD(64);
  __syncthreads();
  if (md.need(0)) { qkt<KW>(pA0, pA1, K_lds, qr, r32, hi, kcolB); partialSM<MODE, Mod>(pA0, pA1, m_reg, mnA, alA, md, 0, hi); } else alA = 1.f;
  int b0 = 0, b1 = 1;
  for (int j = 1; j + 1 < NT; j += 2) {
    const bool n0 = md.need(j - 1), n1 = md.need(j), n2 = md.need(j + 1);
    const int b2 = (b1 == 2) ? 0 : b1 + 1;
    SWRITE(b1); SBAR(); SLOAD((j + 1) * 64); SBAR();
    __syncthreads();
    if (n1) qkt<KW>(pB0, pB1, K_lds + b1 * SHM_K, qr, r32, hi, kcolB);
    if (n0) finishSM(pA0, pA1, alA, l_reg, pa0, pa1, pa2, pa3); SBAR();
    if (n0) pv_all<DV>(o, vb0 + b0 * SHM_V, pa0, pa1, pa2, pa3); if (n1) partialSM<MODE, Mod>(pB0, pB1, m_reg, mnB, alB, md, j, hi); else alB = 1.f;
    RESC(alB);
    SBAR(); SWRITE(b2); SBAR(); if (j + 2 < NT) SLOAD((j + 2) * 64); SBAR();
    __syncthreads();
    if (n2) qkt<KW>(pA0, pA1, K_lds + b2 * SHM_K, qr, r32, hi, kcolB);
    if (n1) finishSM(pB0, pB1, alB, l_reg, pa0, pa1, pa2, pa3); SBAR();
    if (n1) pv_all<DV>(o, vb0 + b1 * SHM_V, pa0, pa1, pa2, pa3); if (n2) partialSM<MODE, Mod>(pA0, pA1, m_reg, mnA, alA, md, j + 1, hi); else alA = 1.f;
    RESC(alA);
    b0 = b2; b1 = (b2 == 2) ? 0 : b2 + 1;
  }
  { const bool t0_ = md.need(NT - 2), t1_ = md.need(NT - 1);
    SBAR(); SWRITE(b1); SBAR();
    __syncthreads();
    if (t1_) qkt<KW>(pB0, pB1, K_lds + b1 * SHM_K, qr, r32, hi, kcolB);
    if (t0_) finishSM(pA0, pA1, alA, l_reg, pa0, pa1, pa2, pa3); SBAR();
    if (t0_) pv_all<DV>(o, vb0 + b0 * SHM_V, pa0, pa1, pa2, pa3); if (t1_) partialSM<MODE, Mod>(pB0, pB1, m_reg, mnB, alB, md, NT - 1, hi); else alB = 1.f;
    RESC(alB);
    if (t1_) { finishSM(pB0, pB1, alB, l_reg, pa0, pa1, pa2, pa3); SBAR();
      pv_all<DV>(o, vb0 + b1 * SHM_V, pa0, pa1, pa2, pa3); } }
#undef SLOAD
#undef SWRITE
#undef RESC
}
}

typedef unsigned short bf16;
typedef float f32x4 __attribute__((ext_vector_type(4)));
typedef unsigned v4u __attribute__((ext_vector_type(4)));
typedef unsigned v2u __attribute__((ext_vector_type(2)));
constexpr int NWAVES = 8;
constexpr int NB = 4, S = 8192, D = 1024, FF = 2816, M = NB * S, DEPTH = 2;
constexpr int NQKV = 3840, NGATE = 3072, INCOLS = 6912;
constexpr float EPS = 1e-6f;
constexpr size_t MiB = 1u << 20;
constexpr size_t WS_WGU1 = 0, WS_WD1 = 11 * MiB, WS_WQKV = 16 * MiB + MiB / 2, WS_WGATE = 24 * MiB, WS_WBR = 30 * MiB, WS_WOUT = 33 * MiB, WS_WGU2 = 35 * MiB, WS_WD2 = 46 * MiB;
constexpr size_t WS_ROPE = 56 * MiB;
constexpr size_t WS_XN = 58 * MiB;
constexpr size_t WS_BIG = 122 * MiB;
constexpr size_t WS_Y = WS_BIG + 192 * MiB;
constexpr size_t WS_OATT = WS_BIG + 240 * MiB;
constexpr size_t WS_CTL = WS_OATT + 96 * MiB;
constexpr size_t WS_L1W = 459 * MiB;
constexpr size_t WS_END = WS_L1W + 52 * MiB;
constexpr int BIGP = 3840;
constexpr int LDS_BYTES = 135168;

__device__ __forceinline__ float wave_sum(float v) {
#pragma unroll
    for (int o = 1; o < 64; o <<= 1) v += __shfl_xor(v, o);
    return v;
}
__device__ __forceinline__ unsigned pk2(float lo, float hi) { return pg8::cvt_pk_bf16(lo, hi); }

template <int MAP> __device__ __forceinline__ int rowmap(int c) {
    if constexpr (MAP == 1) { return c < FF ? ((c >> 7) * 256 + (c & 127)) : ((((c - FF) >> 7) * 256) + 128 + ((c - FF) & 127)); }
    else if constexpr (MAP == 2) { const int head = c >> 6, d = c & 63, hi = d >> 5, dd = d & 31, w2 = dd >> 4, j = dd & 15; return head * 64 + w2 * 32 + hi * 16 + j; }
    else return c;
}
template <int MAP> __device__ __forceinline__ void transpose_item(const float* __restrict__ W, int ldn, int ncol0, int nblk, bf16* __restrict__ WT, int ldk, int koff, int row_off, float* scr, int item, int lane, int ncopies) {
    const int kb = item / nblk, nb = item % nblk, k0 = 64 * kb, n0 = 32 * nb;
    float wv[32];
#pragma unroll
    for (int i = 0; i < 32; ++i) wv[i] = W[(size_t)(k0 + 2 * i + (lane >> 5)) * ldn + ncol0 + n0 + (lane & 31)];
#pragma unroll
    for (int i = 0; i < 32; ++i) scr[(2 * i + (lane >> 5)) * 33 + (lane & 31)] = wv[i];
    asm volatile("s_waitcnt lgkmcnt(0)" ::: "memory");
    const int c = lane & 7;
#pragma unroll
    for (int j = 0; j < 4; ++j) { const int n = (lane >> 3) + 8 * j; const float* s = scr + (8 * c) * 33 + n;
        v4u o; o.x = pk2(s[0 * 33], s[1 * 33]); o.y = pk2(s[2 * 33], s[3 * 33]); o.z = pk2(s[4 * 33], s[5 * 33]); o.w = pk2(s[6 * 33], s[7 * 33]);
        bf16* dst = WT + (size_t)(row_off + rowmap<MAP>(n0 + n)) * ldk + koff + k0 + 8 * c;
        for (int cp = 0; cp < ncopies; ++cp) *(v4u*)(dst + (size_t)cp * 1024) = o; }
    asm volatile("s_waitcnt lgkmcnt(0)" ::: "memory");
}

struct Args {
    unsigned long long in[22];
    unsigned long long out, ws;
    int step_lo, step_hi;
};
typedef const __attribute__((address_space(4))) Args* KArgP;
#define AIN(a, i) ((const float*)(GASQ const float*)((a)->in[i]))
#define AOUT(a) ((float*)(GASQ float*)((a)->out))
#define AWS(a) ((unsigned char*)(GASQ unsigned char*)((a)->ws))

__device__ __forceinline__ void convert_weights(KArgP a, int l, float* scr, int gw, int NGW, int lane) {
    unsigned char* ws = AWS(a) + (l ? WS_L1W : 0);
    const float* gu1 = AIN(a, 2) + (size_t)l * D * 2 * FF; const float* d1 = AIN(a, 3) + (size_t)l * FF * D;
    const float* win = AIN(a, 6) + (size_t)l * D * INCOLS; const float* wbr = AIN(a, 14) + (size_t)l * 3 * 512 * D; const float* wout = AIN(a, 16) + (size_t)l * D * D;
    const float* gu2 = AIN(a, 19) + (size_t)l * D * 2 * FF; const float* d2 = AIN(a, 20) + (size_t)l * FF * D;
    constexpr int I_GU = (D / 64) * (2 * FF / 32), I_D = (FF / 64) * (D / 32), I_QKV = (D / 64) * (NQKV / 32), I_G = (D / 64) * (NGATE / 32), I_BR = (512 / 64) * (D / 32), I_O = (D / 64) * (D / 32);
    constexpr int NITEMS = 2 * I_GU + 2 * I_D + I_QKV + I_G + 3 * I_BR + I_O;
    for (int it = gw; it < NITEMS; it += NGW) {
        int r = it;
        if (r < I_GU) { transpose_item<1>(gu1, 2 * FF, 0, 2 * FF / 32, (bf16*)(ws + WS_WGU1), D, 0, 0, scr, r, lane, 1); continue; } r -= I_GU;
        if (r < I_GU) { transpose_item<1>(gu2, 2 * FF, 0, 2 * FF / 32, (bf16*)(ws + WS_WGU2), D, 0, 0, scr, r, lane, 1); continue; } r -= I_GU;
        if (r < I_D) { transpose_item<0>(d1, D, 0, D / 32, (bf16*)(ws + WS_WD1), FF, 0, 0, scr, r, lane, 1); continue; } r -= I_D;
        if (r < I_D) { transpose_item<0>(d2, D, 0, D / 32, (bf16*)(ws + WS_WD2), FF, 0, 0, scr, r, lane, 1); continue; } r -= I_D;
        if (r < I_QKV) { transpose_item<2>(win, INCOLS, 0, NQKV / 32, (bf16*)(ws + WS_WQKV), D, 0, 0, scr, r, lane, 1); continue; } r -= I_QKV;
        if (r < I_G) { transpose_item<0>(win, INCOLS, NQKV, NGATE / 32, (bf16*)(ws + WS_WGATE), D, 0, 0, scr, r, lane, 1); continue; } r -= I_G;
        if (r < 3 * I_BR) { const int br = r / I_BR; transpose_item<0>(wbr + (size_t)br * 512 * D, D, 0, D / 32, (bf16*)(ws + WS_WBR), 512, 0, br * D, scr, r % I_BR, lane, 1); continue; } r -= 3 * I_BR;
        transpose_item<0>(wout, D, 0, D / 32, (bf16*)(ws + WS_WOUT), D, 0, 0, scr, r, lane, 1);
    }
}

__device__ __forceinline__ void row_phase(const float* hin, float* hout, const float* Y, const float* gpost, float coef,
                                          const float* gnext, bf16* XN, int gw, int NGW, int lane) {
    f32x4 gp[4], gn[4];
#pragma unroll
    for (int j = 0; j < 4; ++j) { gp[j] = Y ? *((const f32x4*)gpost + lane + 64 * j) : (f32x4){0.f, 0.f, 0.f, 0.f}; gn[j] = gnext ? *((const f32x4*)gnext + lane + 64 * j) : (f32x4){0.f, 0.f, 0.f, 0.f}; }
    for (int t_ = 0; t_ < 8; ++t_) {
        int m[2];
#pragma unroll
        for (int q = 0; q < 2; ++q) { const int tt = t_ + 8 * q;
            m[q] = (NGW < 0) ? ((((q == 0) ? (gw >> 16) : (gw >> 16) + 8) << 8) + (gw & 0xffff) + t_) : (gw + tt * NGW); }
        f32x4 v[2][4]; v2u yw[2][4];
#pragma unroll
        for (int q = 0; q < 2; ++q) { const int mm = m[q] < M ? m[q] : 0;
            const f32x4* hr = (const f32x4*)(hin + (size_t)mm * D) + lane;
#pragma unroll
            for (int j = 0; j < 4; ++j) v[q][j] = hr[64 * j];
            if (Y) { const v2u* yr = (const v2u*)((const bf16*)Y + (size_t)mm * D) + lane;
#pragma unroll
                for (int j = 0; j < 4; ++j) yw[q][j] = yr[64 * j]; } }
#pragma unroll
        for (int q = 0; q < 2; ++q) {
            if (m[q] >= M) continue;
            if (Y) {
                f32x4 y[4]; float s = 0.f;
#pragma unroll
                for (int j = 0; j < 4; ++j) { const v2u w = yw[q][j]; y[j] = (f32x4){pg8::bf_lo(w.x), pg8::bf_hi(w.x), pg8::bf_lo(w.y), pg8::bf_hi(w.y)}; s += (y[j].x * y[j].x + y[j].y * y[j].y) + (y[j].z * y[j].z + y[j].w * y[j].w); }
                const float r = coef * __builtin_amdgcn_rsqf(wave_sum(s) * (1.f / D) + EPS);
#pragma unroll
                for (int j = 0; j < 4; ++j) v[q][j] = v[q][j] + y[j] * gp[j] * r;
                f32x4* ho = (f32x4*)(hout + (size_t)m[q] * D) + lane;
#pragma unroll
                for (int j = 0; j < 4; ++j) ho[64 * j] = v[q][j];
            }
            if (gnext) {
                float s2 = 0.f;
#pragma unroll
                for (int j = 0; j < 4; ++j) s2 += (v[q][j].x * v[q][j].x + v[q][j].y * v[q][j].y) + (v[q][j].z * v[q][j].z + v[q][j].w * v[q][j].w);
                const float r2 = __builtin_amdgcn_rsqf(wave_sum(s2) * (1.f / D) + EPS);
                unsigned long long* o8 = (unsigned long long*)(XN + (size_t)m[q] * D) + lane;
#pragma unroll
                for (int j = 0; j < 4; ++j) { const f32x4 t = v[q][j] * gn[j] * r2;
                    o8[64 * j] = (unsigned long long)pk2(t.x, t.y) | ((unsigned long long)pk2(t.z, t.w) << 32); }
            }
        }
    }
}

#ifndef ATTMASK
#define ATTMASK 7
#endif
template <int AMODE> __device__ __forceinline__ void attention_phase(KArgP a, int l, char* lds, int vcu, int G) {
    using namespace att;
    const int tid = opaque_tid(), wid = tid >> 6, lane = tid & 63, r32 = lane & 31, hi = lane >> 5;
    const bf16* QKV = (const bf16*)(AWS(a) + WS_BIG);
    bf16* OA = (bf16*)(AWS(a) + WS_OATT); bf16* OB = OA + (size_t)M * 512; bf16* OC = OB + (size_t)M * 512;
    float* wsf = (float*)(lds + OFF_WS) + wid * 64;
    float lam = 0.f, lam_init = 0.f;
    if constexpr (AMODE == 0) { const float q1 = AIN(a, 9)[l * 64 + lane], k1 = AIN(a, 10)[l * 64 + lane], q2 = AIN(a, 11)[l * 64 + lane], k2 = AIN(a, 12)[l * 64 + lane];
      lam_init = 0.8f - 0.6f * __expf(-0.3f * (float)l);
      lam = __expf(wave_sum(q1 * k1)) - __expf(wave_sum(q2 * k2)) + lam_init; }
    if constexpr (AMODE == 0)
    for (int k_ = 0; k_ < (vcu < 0 ? 4 : (1024 - vcu + G - 1) / G); ++k_) {
        const int u = (vcu < 0) ? ((((-vcu - 1) >> 8) << 8) + (k_ << 6) + ((-vcu - 1) & 63)) : (vcu + k_ * G);
        const int bh = u >> 6, qb = u & 63, b = bh >> 2, h = bh & 3, t = wid >> 2;
        const long tok0 = (long)b * S + qb * 128;
        const bf16* Qw = QKV + (tok0 + (wid & 3) * 32 + r32) * LDQKV + 2304 + h * 128 + t * 64 + hi * 8;
        const bf16* Kt = QKV + (long)b * S * LDQKV + 2816 + h * 128;
        const bf16* Vt = QKV + (long)b * S * LDQKV + 3328 + h * 128;
        f32x16 o[4]; float m_reg, l_reg; ModC md{0};
        attn_loop<128, 128, 2, ModC>(Qw, Kt, Vt, S / 64, t * 128, lds, md, o, m_reg, l_reg);
        if (hi == 0) wsf[r32] = l_reg;
        asm volatile("s_waitcnt lgkmcnt(0)" ::: "memory");
        float rli[16];
#pragma unroll
        for (int r = 0; r < 16; ++r) rli[r] = __builtin_amdgcn_rcpf(wsf[crow(r, hi)]);
        __syncthreads();
        float* ex = (float*)lds + ((wid & 3) * 64) * 64 + lane;
        if (t == 1) {
#pragma unroll
            for (int d0 = 0; d0 < 4; ++d0)
#pragma unroll
                for (int r = 0; r < 16; ++r) ex[(d0 * 16 + r) * 64] = o[d0][r] * rli[r];
        }
        __syncthreads();
        if (t == 0) {
            const float* gsub = AIN(a, 13) + l * 128;
            float gg[4];
#pragma unroll
            for (int d0 = 0; d0 < 4; ++d0) gg[d0] = gsub[d0 * 32 + r32] * (1.0f - lam_init);
#pragma unroll
            for (int r = 0; r < 16; ++r) {
                float dv[4]; float ss = 0.f;
#pragma unroll
                for (int d0 = 0; d0 < 4; ++d0) { dv[d0] = o[d0][r] * rli[r] - lam * ex[(d0 * 16 + r) * 64]; ss += dv[d0] * dv[d0]; }
                ss += __shfl_xor(ss, 1); ss += __shfl_xor(ss, 2); ss += __shfl_xor(ss, 4); ss += __shfl_xor(ss, 8); ss += __shfl_xor(ss, 16);
                const float rn = __builtin_amdgcn_rsqf(ss * (1.f / 128.f) + EPS);
                bf16* op = OC + (tok0 + (wid & 3) * 32 + crow(r, hi)) * 512 + h * 128 + r32;
#pragma unroll
                for (int d0 = 0; d0 < 4; ++d0) op[d0 * 32] = (bf16)(pk2(dv[d0] * rn * gg[d0], 0.f) & 0xffffu);
            }
        }
        __syncthreads();
    }
    if constexpr (AMODE == 1)
    for (int k_ = 0; k_ < (vcu < 0 ? 4 : (1024 - vcu + G - 1) / G); ++k_) {
        const int u = (vcu < 0) ? ((((-vcu - 1) >> 8) << 8) + (k_ << 6) + ((-vcu - 1) & 63)) : (vcu + k_ * G);
        const int bh = u >> 5, qb = u & 31, b = bh >> 3, h = bh & 7;
        const long tok0 = (long)b * S + qb * 256;
        const int t0 = (4 * qb - 4) < 0 ? 0 : (4 * qb - 4), t1 = (4 * qb + 8) > 128 ? 128 : (4 * qb + 8);
        { const float* rp = AIN(a, 7) + ((size_t)l * 8 + h) * 465; float* tb = (float*)(lds + OFF_RPB); if (tid < 465) tb[tid] = rp[tid] * 8.0f; }
        const int qtok = qb * 256 + wid * 32 + r32;
        ModA md; md.qrow = qtok >> 6; md.qc = qtok & 63; md.cs = (md.qc - 8) < 0 ? 0 : ((md.qc - 8) > 48 ? 48 : (md.qc - 8)); md.rs = (md.qrow - 4) < 0 ? 0 : ((md.qrow - 4) > 120 ? 120 : (md.qrow - 4));
        md.rs = __builtin_amdgcn_readfirstlane(md.rs); md.t0 = t0; md.rpb = (const float*)(lds + OFF_RPB);
        const bf16* Qw = QKV + (tok0 + wid * 32 + r32) * LDQKV + 0 + h * 64 + hi * 8;
        const bf16* Kt = QKV + ((long)b * S + t0 * 64) * LDQKV + 512 + h * 64;
        const bf16* Vt = QKV + ((long)b * S + t0 * 64) * LDQKV + 1024 + h * 64;
        f32x16 o[2]; float m_reg, l_reg;
        attn_loop<64, 64, 0, ModA>(Qw, Kt, Vt, t1 - t0, 0, lds, md, o, m_reg, l_reg);
        if (hi == 0) wsf[r32] = l_reg;
        asm volatile("s_waitcnt lgkmcnt(0)" ::: "memory");
#pragma unroll
        for (int r = 0; r < 16; ++r) { const float rl = __builtin_amdgcn_rcpf(wsf[crow(r, hi)]);
            bf16* op = OA + (tok0 + wid * 32 + crow(r, hi)) * 512 + h * 64 + r32;
#pragma unroll
            for (int d0 = 0; d0 < 2; ++d0) op[d0 * 32] = (bf16)(pk2(o[d0][r] * rl, 0.f) & 0xffffu); }
        __syncthreads();
    }
    if constexpr (AMODE == 2)
    for (int k_ = 0; k_ < (vcu < 0 ? 4 : (1024 - vcu + G - 1) / G); ++k_) {
        const int u = (vcu < 0) ? ((((-vcu - 1) >> 8) << 8) + (k_ << 6) + ((-vcu - 1) & 63)) : (vcu + k_ * G);
        const int bh = u >> 5, qb = u & 31, b = bh >> 3, h = bh & 7, kvh = h >> 2;
        const long tok0 = (long)b * S + qb * 256;
        const int k0 = (qb * 256 - 128) < 0 ? 0 : (qb * 256 - 128), k1 = (qb * 256 + 384) > S ? S : (qb * 256 + 384);
        ModB md; md.d0 = k0 - (qb * 256 + wid * 32 + r32) + 4 * hi;
        { const int qmin = qb * 256 + __builtin_amdgcn_readfirstlane(wid) * 32; md.lo = qmin - 128 - k0; md.hi = qmin + 31 + 128 - k0; }
        const bf16* Qw = QKV + (tok0 + wid * 32 + r32) * LDQKV + 1536 + h * 64 + hi * 8;
        const bf16* Kt = QKV + ((long)b * S + k0) * LDQKV + 2048 + kvh * 64;
        const bf16* Vt = QKV + ((long)b * S + k0) * LDQKV + 2176 + kvh * 64;
        f32x16 o[2]; float m_reg, l_reg;
        attn_loop<64, 64, 1, ModB>(Qw, Kt, Vt, (k1 - k0) / 64, 0, lds, md, o, m_reg, l_reg);
        l_reg += __expf(AIN(a, 8)[l * 8 + h] - SCALE * m_reg);
        if (hi == 0) wsf[r32] = l_reg;
        asm volatile("s_waitcnt lgkmcnt(0)" ::: "memory");
#pragma unroll
        for (int r = 0; r < 16; ++r) { const float rl = __builtin_amdgcn_rcpf(wsf[crow(r, hi)]);
            bf16* op = OB + (tok0 + wid * 32 + crow(r, hi)) * 512 + h * 64 + r32;
#pragma unroll
            for (int d0 = 0; d0 < 2; ++d0) op[d0 * 32] = (bf16)(pk2(o[d0][r] * rl, 0.f) & 0xffffu); }
        __syncthreads();
    }
}

#ifndef PHMASK
#define PHMASK 0xffff
#endif
#define PH(b) if constexpr ((PHMASK >> (b)) & 1)
template <int KIND>
__global__ void __launch_bounds__(NWAVES * 64, 2) fwd_megakernel(Args a_unused) {
    constexpr bool ALL = KIND < 0;
    extern __shared__ __attribute__((aligned(16))) unsigned char lds[];
    cg::grid_group grid = cg::this_grid();
    KArgP ap0 = (KArgP)__builtin_amdgcn_kernarg_segment_ptr();
#define ARGS() ({ KArgP p_ = ap0; asm volatile("" : "+s"(p_)); p_; })
    const int G0 = gridDim.x, bx0 = blockIdx.x;
    PG8_LAS unsigned char* ldsL = (PG8_LAS unsigned char*)lds;

    const int step_lo = ARGS()->step_lo, step_hi = ARGS()->step_hi;
    if ((ALL || KIND == 9) && step_lo < 0) {
        KArgP a = ARGS(); const int G = G0, bx = bx0;
        const int tid = threadIdx.x, lane = tid & 63, wave = __builtin_amdgcn_readfirstlane(tid >> 6);
        const int gw = bx * NWAVES + wave, NGW = G * NWAVES;
        float* scr = (float*)lds + wave * (64 * 33);
        float* cosT = (float*)(AWS(a) + WS_ROPE); float* sinT = cosT + 8192 * 32;
        if (bx == 0 && tid < 68) { ((unsigned*)(AWS(a) + WS_CTL))[tid * 64] = 0u; ((unsigned*)(AWS(a) + WS_CTL))[tid * 64 + 1] = 0u; }
        PH(0) { convert_weights(a, 0, scr, gw, NGW, lane); convert_weights(a, 1, scr, gw, NGW, lane); }
        for (int i = bx * 512 + tid; i < 8192 * 32; i += G * 512) { const int pos = i >> 5, d = i & 31; const float inv = exp2f(-(float)d * (13.287712379549449f / 32.0f)); const float ang = (float)pos * inv; float sn, cs; sincosf(ang, &sn, &cs); cosT[i] = cs; sinT[i] = sn; }
        PH(1) row_phase(AIN(a, 0), nullptr, nullptr, nullptr, 0.f, AIN(a, 1), (bf16*)(AWS(a) + WS_XN), gw, NGW, lane);
        __syncthreads();
        if (step_hi > 0) gsync(grid);
    }

    constexpr int NS = 14;
    unsigned gtarget = 0u, gsame = 0u, starget = 0u;
#ifndef MAXSTEP
#define MAXSTEP (14 * DEPTH)
#endif
    for (int step = (step_lo < 0 ? 0 : step_lo); step < step_hi; ++step) {
#ifdef DBG_DUMP
        if ((ALL || KIND == 10) && step == MAXSTEP) {
            KArgP a = ARGS(); float* o = AOUT(a); const bf16* src = (const bf16*)(AWS(a) + (size_t)DBG_DUMP_MIB * MiB);
            const unsigned t0_ = (unsigned)bx0 * 512u + (unsigned)opaque_tid();
#pragma nounroll
            for (unsigned i = t0_; i < (unsigned)(M * D); i += (unsigned)G0 * 512u) {
                float v = (DBG_DUMP_N == 0) ? ((const float*)src)[i] : ((i < (unsigned)DBG_DUMP_LIMIT) ? __uint_as_float((unsigned)src[i] << 16) : 0.f);
                if (DBG_DUMP_N > 1) v += __uint_as_float((unsigned)src[(size_t)i + DBG_DUMP_STRIDE] << 16);
                if (DBG_DUMP_N > 2) v += __uint_as_float((unsigned)src[(size_t)i + 2 * DBG_DUMP_STRIDE] << 16);
                o[i] = v; }
            break;
        }
#endif
        const int l = step / NS, sidx = step % NS;
        const int G = opaque_s(G0), bx = opaque_s(bx0);
        const bool grp = (G == 256);
        if (step == 0 && grp && threadIdx.x == 0)
            __hip_atomic_fetch_or((unsigned*)(AWS(ARGS()) + WS_CTL) + (((bx & 7) * 8 + ((bx >> 3) & 7)) * 64) + 1, 1u << ((unsigned)__builtin_amdgcn_s_getreg((3 << 11) | 20) & 0xFu), __ATOMIC_RELAXED, __HIP_MEMORY_SCOPE_AGENT);
        KArgP a = ARGS();
        unsigned char* ws = AWS(a); unsigned char* wsw = ws + (l ? WS_L1W : 0);
        bf16* XN = (bf16*)(ws + WS_XN); bf16* BIG = (bf16*)(ws + WS_BIG); float* Y = (float*)(ws + WS_Y);
        if ((ALL || KIND == 0) && (sidx == 0 || sidx == 11)) {
            PH(2) { pg8::Gemm g{XN, (const bf16*)(wsw + (sidx == 0 ? WS_WGU1 : WS_WGU2)), M, 2 * FF, D, 1 << 30, 0}; pg8::StaticOrder So; So.init(M, 2 * FF, G, bx);
              pg8::EpiSwiGLU E{BIG, BIGP}; pg8::gemm_phase<pg8::EpiSwiGLU, pg8::StaticOrder, true, true>(ldsL, g, So, E); }
        } else if ((ALL || KIND == 1) && (sidx == 1 || sidx == 9 || sidx == 12)) {
            PH(3) { const int K = (sidx == 9) ? D : FF; const size_t wo = (sidx == 1) ? WS_WD1 : (sidx == 9 ? WS_WOUT : WS_WD2);
              pg8::Gemm g{BIG, (const bf16*)(wsw + wo), M, D, K, 1 << 30, 0, BIGP}; pg8::StaticOrder So; So.init(M, D, G, bx);
              pg8::EpiY16 E{XN, D}; pg8::gemm_phase<pg8::EpiY16, pg8::StaticOrder, true, true>(ldsL, g, So, E); }
        } else if ((ALL || KIND == 2) && (sidx == 2 || sidx == 10 || sidx == 13)) {
            PH(1) { const int tid = opaque_tid(), lane = tid & 63, wave = __builtin_amdgcn_readfirstlane(tid >> 6);
              const int gw = grp ? ((((bx & 7) * 16 + ((bx >> 3) & 7)) << 16) | ((bx >> 6) * 64 + wave * 8)) : (bx * NWAVES + wave), NGW = grp ? -1 : G * NWAVES;
              const float* hin = (step == 2) ? AIN(a, 0) : AOUT(a);
              const float* gpost = AIN(a, sidx == 2 ? 4 : (sidx == 10 ? 17 : 21)) + l * D; const float coef = (sidx == 10) ? 1.0f : 0.5f;
              const float* gnext = (sidx == 2) ? AIN(a, 5) + l * D : (sidx == 10 ? AIN(a, 18) + l * D : (l + 1 < DEPTH ? AIN(a, 1) + (l + 1) * D : nullptr));
              row_phase(hin, AOUT(a), (const float*)XN, gpost, coef, gnext, XN, gw, NGW, lane); }
        } else if ((ALL || KIND == 3) && sidx == 3) {
            PH(4) { const float* cosT = (const float*)(ws + WS_ROPE); pg8::Gemm g{XN, (const bf16*)(wsw + WS_WQKV), M, NQKV, D, 1 << 30, 0}; pg8::StaticOrder So; So.init(M, NQKV, G, bx);
              pg8::EpiQKV E{BIG, NQKV, cosT, cosT + 8192 * 32}; pg8::gemm_phase<pg8::EpiQKV, pg8::StaticOrder, true, true>(ldsL, g, So, E); }
        } else if ((ALL || KIND == 4) && sidx == 4) {
            PH(5) { const int vcu = grp ? -(1 + ((((bx & 7) >> 1) << 8) | (((bx & 1) << 5) | (bx >> 3)))) : ((G % 8 == 0) ? (bx % 8) * (G / 8) + bx / 8 : bx); attention_phase<0>(a, l, (char*)lds, vcu, G); }
        } else if ((ALL || KIND == 5) && sidx == 5) {
            PH(8) { const int vcu = grp ? -(1 + ((((bx & 7) >> 1) << 8) | (((bx & 1) << 5) | (bx >> 3)))) : ((G % 8 == 0) ? (bx % 8) * (G / 8) + bx / 8 : bx); attention_phase<1>(a, l, (char*)lds, vcu, G); }
        } else if ((ALL || KIND == 6) && sidx == 6) {
            PH(9) { const int vcu = grp ? -(1 + ((((bx & 7) >> 1) << 8) | (((bx & 1) << 5) | (bx >> 3)))) : ((G % 8 == 0) ? (bx % 8) * (G / 8) + bx / 8 : bx); attention_phase<2>(a, l, (char*)lds, vcu, G); }
        } else if ((ALL || KIND == 7) && sidx == 7) {
            PH(6) { pg8::Gemm g{XN, (const bf16*)(wsw + WS_WGATE), M, NGATE, D, 1 << 30, 0}; pg8::StaticOrder So; So.init(M, NGATE, G, bx);
              pg8::EpiGate E{BIG, BIGP, AIN(a, 15) + (size_t)l * NGATE}; pg8::gemm_phase<pg8::EpiGate, pg8::StaticOrder, true, true>(ldsL, g, So, E); }
        } else if ((ALL || KIND == 8) && sidx == 8) {
            PH(7) { for (int br = 0; br < 3; ++br) {
                pg8::Gemm g{(const bf16*)(ws + WS_OATT) + (size_t)br * M * 512, (const bf16*)(wsw + WS_WBR) + (size_t)br * D * 512, M, D, 512, 1 << 30, 0, 0}; pg8::StaticOrder So; So.init(M, D, G, bx);
                pg8::EpiBranchAcc E{BIG, BIGP, br * D, br == 0}; pg8::gemm_phase<pg8::EpiBranchAcc, pg8::StaticOrder, true, true>(ldsL, g, So, E); } }
        }
        if (step + 1 < step_hi && sidx != 4 && sidx != 5) {
            if (grp && (sidx == 3 || sidx == 6)) set_sync((unsigned*)(AWS(ARGS()) + WS_CTL) + (64 + ((bx & 7) >> 1)) * 64, starget);
            else if (grp) group_sync((unsigned*)(AWS(ARGS()) + WS_CTL) + (((bx & 7) * 8 + ((bx >> 3) & 7)) * 64), gtarget, gsame);
            else gsync(grid);
        }
    }

#ifdef DBG_SANITIZE
    gsync(grid);
    { KArgP a = ARGS(); float* o = AOUT(a); for (size_t i = (size_t)bx0 * 512 + threadIdx.x; i < (size_t)M * D; i += (size_t)G0 * 512) { float v = o[i]; if (!(fabsf(v) < 1e30f)) o[i] = 777.f; } }
#endif
}

#ifndef MK_PER_PHASE
#define MK_PER_PHASE 0
#endif
#ifdef DBG_DUMP
#define DBG_DUMP_EXTRA 1
#else
#define DBG_DUMP_EXTRA 0
#endif
extern "C" void kernel_launch(void* const* d_in, const int* in_sizes, int n_in, void* d_out, int out_size, void* d_ws, size_t ws_size, hipStream_t stream) {
    static int grid = 0;
    if (grid == 0) {
        if (n_in != 22 || in_sizes[0] != M * D || out_size != M * D || ws_size < WS_END) { fprintf(stderr, "kernel_launch: unexpected shapes (n_in %d in0 %d out %d ws %zu, need ws >= %zu); nothing launched\n", n_in, n_in > 0 ? in_sizes[0] : -1, out_size, ws_size, (size_t)WS_END); grid = -1; return; }
        int dev = 0, cus = 0, per_cu = 0;
        if (hipGetDevice(&dev) != hipSuccess || hipDeviceGetAttribute(&cus, hipDeviceAttributeMultiprocessorCount, dev) != hipSuccess) { grid = -1; return; }
        bool okattr = true;
#define SETA(k) okattr = okattr && (hipFuncSetAttribute((const void*)fwd_megakernel<k>, hipFuncAttributeMaxDynamicSharedMemorySize, LDS_BYTES) == hipSuccess)
        SETA(-1);
#if MK_PER_PHASE
        SETA(0); SETA(1); SETA(2); SETA(3); SETA(4); SETA(5); SETA(6); SETA(7); SETA(8); SETA(9); SETA(10);
#endif
        if (!okattr) { fprintf(stderr, "kernel_launch: hipFuncSetAttribute failed\n"); grid = -1; return; }
        if (hipOccupancyMaxActiveBlocksPerMultiprocessor(&per_cu, (const void*)fwd_megakernel<-1>, NWAVES * 64, LDS_BYTES) != hipSuccess || per_cu < 1) per_cu = 1;
        (void)hipGetLastError();
        grid = cus;
    }
    if (grid < 0) return;
    Args a{};
    for (int i = 0; i < 22; ++i) a.in[i] = (unsigned long long)(uintptr_t)d_in[i];
    a.out = (unsigned long long)(uintptr_t)d_out; a.ws = (unsigned long long)(uintptr_t)d_ws;
#ifdef DBG_DUMP
#define DBG_DUMP_EXTRA 1
#else
#define DBG_DUMP_EXTRA 0
#endif
#ifndef MK_PER_PHASE
#define MK_PER_PHASE 0
#endif
#if MK_PER_PHASE
    {
        for (int s = -1; s < MAXSTEP + DBG_DUMP_EXTRA; ++s) { a.step_lo = s; a.step_hi = s + 1;
            const int sx = s < 0 ? -1 : s % 14;
            const int kind = (s < 0) ? 9 : (s == MAXSTEP && DBG_DUMP_EXTRA) ? 10 : (sx == 0 || sx == 11) ? 0 : (sx == 1 || sx == 9 || sx == 12) ? 1 : (sx == 2 || sx == 10 || sx == 13) ? 2 : sx;
#define LK(k) case k: hipLaunchKernelGGL(fwd_megakernel<k>, dim3(grid), dim3(NWAVES * 64), LDS_BYTES, stream, a); break;
            switch (kind) { LK(0) LK(1) LK(2) LK(3) LK(4) LK(5) LK(6) LK(7) LK(8) LK(9) LK(10) }
        }
    }
#else
    {
        a.step_lo = -1; a.step_hi = MAXSTEP + DBG_DUMP_EXTRA;
        void* args[] = {&a};
        hipError_t e = hipLaunchCooperativeKernel((const void*)fwd_megakernel<-1>, dim3(grid), dim3(NWAVES * 64), args, LDS_BYTES, stream);
        if (e != hipSuccess) fprintf(stderr, "kernel_launch: cooperative launch failed: %s (grid %d)\n", hipGetErrorString(e), grid);
    }
#endif
}
```
